# Optimizing an MI355X kernel written in HIP

```python
import math
import jax, jax.numpy as jnp
from jax import lax
import numpy as np

D_MODEL = 1024
BATCH = 32
SEQ = 256
DEPTH = 2
DEC_BATCH = 2
DEC_SEQ = 2048
PAST_LEN = 256

GRID_W = 64
HEAD_DIM = 64
ROPE_BASE = 10000.0
N_EVEN = (DEPTH + 1) // 2
N_ODD = DEPTH // 2
MIX_WIDTH = D_MODEL
A_HEADS = D_MODEL // 128
A_KV_HEADS = A_HEADS // 4
A_GROUP = A_HEADS // A_KV_HEADS
A_WIDTH = A_HEADS * HEAD_DIM
A_KV_WIDTH = A_KV_HEADS * HEAD_DIM
WINDOW = 128
BLOCK = 128
B_HEADS = D_MODEL // 128
B_WIDTH = B_HEADS * HEAD_DIM
DECAY_LORA = 64
AAA_LORA = 64
B_SHIFT_WIDTH = 3 * B_WIDTH + DECAY_LORA + AAA_LORA
C_HEADS = D_MODEL // 128
C_QK_DIM = 64
C_V_DIM = 2 * C_QK_DIM
C_WIDTH = C_HEADS * C_V_DIM
EVEN_IN = A_WIDTH + 2 * A_KV_WIDTH + A_WIDTH + B_SHIFT_WIDTH + B_WIDTH
ODD_IN = 2 * (C_HEADS * 2 * C_QK_DIM) + C_WIDTH + C_WIDTH
NORM_EPS = 1e-6
RWKV_LN_EPS = 64e-5
SUBLN_EPS = 1e-5
NEG_INF = -1e30

kernel_name = "hybrid_diffusion_prefix_step"

F32 = jnp.float32


def split_cols(p, sizes):
    idx = np.cumsum(sizes)[:-1].tolist()
    return jnp.split(p, idx, axis=-1)


def rms_norm(x, gain, eps=NORM_EPS):
    xf = x.astype(F32)
    y = xf * lax.rsqrt(jnp.mean(xf * xf, -1, keepdims=True) + eps)
    return (y * gain.astype(F32)).astype(x.dtype)


def modulation(cvec, ada_w, ada_b):
    m = jax.nn.silu(cvec) @ ada_w + ada_b
    return split_cols(m, [D_MODEL] * 3)


def axial_rope_tables(T, d):
    nf = d // 4
    inv = 1.0 / (ROPE_BASE ** (jnp.arange(nf, dtype=F32) / nf))
    t = jnp.arange(T)
    row = (t // GRID_W).astype(F32)
    col = (t % GRID_W).astype(F32)
    ang_r = row[:, None] * inv[None]
    ang_c = col[:, None] * inv[None]
    ang = jnp.concatenate([ang_r, ang_r, ang_c, ang_c], -1)
    return jnp.cos(ang), jnp.sin(ang)


def apply_rope(x, cos, sin):
    x1, x2, x3, x4 = jnp.split(x, 4, axis=-1)
    rot = jnp.concatenate([-x2, x1, -x4, x3], -1)
    return x * cos[None, :, None, :].astype(x.dtype) + rot * sin[None, :, None, :].astype(x.dtype)


def sink_softmax(s, sink):
    m = jnp.maximum(jnp.max(s, -1, keepdims=True), sink)
    e = jnp.exp(s - m)
    return e / (jnp.sum(e, -1, keepdims=True) + jnp.exp(sink - m))


def gqa_context(q, k, v, sink):
    Bn, C = q.shape[:2]
    qg = q.reshape(Bn, C, A_KV_HEADS, A_GROUP, HEAD_DIM)
    s = jnp.einsum('bqgrd,bkgd->bgrqk', qg, k, preferred_element_type=F32) * (HEAD_DIM ** -0.5)
    p = sink_softmax(s, sink.astype(F32).reshape(1, A_KV_HEADS, A_GROUP, 1, 1))
    o = jnp.einsum('bgrqk,bkgd->bqgrd', p.astype(v.dtype), v)
    return o.reshape(Bn, C, A_WIDTH)


def gqa_window_latent(q, k, v, k_ctx, v_ctx, sink):
    Bn, T = q.shape[:2]
    nb = T // BLOCK
    C = k_ctx.shape[1]
    qb = q.reshape(Bn, nb, BLOCK, A_KV_HEADS, A_GROUP, HEAD_DIM)

    def band(t):
        tp = jnp.pad(t, ((0, 0), (BLOCK, BLOCK), (0, 0), (0, 0)))
        tp = tp.reshape(Bn, nb + 2, BLOCK, A_KV_HEADS, HEAD_DIM)
        return jnp.concatenate([tp[:, :-2], tp[:, 1:-1], tp[:, 2:]], axis=2)

    kb, vb = band(k), band(v)
    blk = jnp.arange(nb)[:, None] * BLOCK
    qpos = blk + jnp.arange(BLOCK)[None]
    kpos = blk + jnp.arange(3 * BLOCK)[None] - BLOCK
    valid = ((jnp.abs(qpos[:, :, None] - kpos[:, None, :]) <= WINDOW)
             & (kpos[:, None, :] >= 0) & (kpos[:, None, :] < T))
    scale = HEAD_DIM ** -0.5
    s_loc = jnp.einsum('bnigrd,bnjgd->bngrij', qb, kb, preferred_element_type=F32) * scale
    s_loc = jnp.where(valid[None, :, None, None], s_loc, NEG_INF)
    s_ctx = jnp.einsum('bnigrd,bcgd->bngric', qb, k_ctx, preferred_element_type=F32) * scale
    s = jnp.concatenate([s_ctx, s_loc], -1)
    p = sink_softmax(s, sink.astype(F32).reshape(1, 1, A_KV_HEADS, A_GROUP, 1, 1)).astype(v.dtype)
    o = (jnp.einsum('bngric,bcgd->bnigrd', p[..., :C], v_ctx)
         + jnp.einsum('bngrij,bnjgd->bnigrd', p[..., C:], vb))
    return o.reshape(Bn, T, A_WIDTH)


def centred_shift(p):
    z = jnp.zeros_like(p[:, :1])
    prev = jnp.concatenate([z, p[:, :-1]], 1)
    nxt = jnp.concatenate([p[:, 1:], z], 1)
    return 0.5 * (prev + nxt)


def heads_b(t):
    return t.reshape(t.shape[:-1] + (B_HEADS, HEAD_DIM))


def rwkv_scan(S0, r, decay, kk, a, k, v, reverse):
    def step(S, inp):
        r_t, w_t, kk_t, a_t, k_t, v_t = inp
        sa = jnp.einsum('bhvk,bhk->bhv', S, -kk_t)
        S = (S * w_t[:, :, None, :] + sa[..., None] * (kk_t * a_t)[:, :, None, :]
             + v_t[..., None] * k_t[:, :, None, :])
        return S, jnp.einsum('bhvk,bhk->bhv', S, r_t)

    xs = tuple(jnp.moveaxis(t, 1, 0) for t in (r, decay, kk, a, k, v))
    S, ys = lax.scan(step, S0, xs, reverse=reverse)
    return S, jnp.moveaxis(ys, 0, 1)


def rwkv_mix(p, S0_fwd, S0_bwd, mu, w0, w2, a0, a2, k_k, k_a, r_k, ln_w, ln_b):
    pf = p.astype(F32)
    xf = pf + (centred_shift(pf) - pf) * mu.astype(F32)
    r, k, v, wlo, alo = split_cols(xf, [B_WIDTH] * 3 + [DECAY_LORA, AAA_LORA])
    w = -jax.nn.softplus(-(w0.astype(F32)[:, None, None, :]
                           + jnp.einsum('btl,zlc->zbtc', jnp.tanh(wlo), w2.astype(F32)))) - 0.5
    decay = jnp.exp(-jnp.exp(w))
    a = jax.nn.sigmoid(a0.astype(F32)[:, None, None, :]
                       + jnp.einsum('btl,zlc->zbtc', alo, a2.astype(F32)))
    kk = heads_b(k * k_k.astype(F32))
    kk = kk / jnp.maximum(jnp.sqrt(jnp.sum(kk * kk, -1, keepdims=True)), 1e-12)
    k_eff = k[None] * (1.0 + (a - 1.0) * k_a.astype(F32))
    rh, vh = heads_b(r), heads_b(v)
    S_f, y_f = rwkv_scan(S0_fwd.astype(F32), rh, heads_b(decay[0]), kk, heads_b(a[0]),
                         heads_b(k_eff[0]), vh, False)
    S_b, y_b = rwkv_scan(S0_bwd.astype(F32), rh, heads_b(decay[1]), kk, heads_b(a[1]),
                         heads_b(k_eff[1]), vh, True)
    y = y_f + y_b
    mean = jnp.mean(y, -1, keepdims=True)
    var = jnp.mean(jnp.square(y - mean), -1, keepdims=True)
    y = (y - mean) * lax.rsqrt(var + RWKV_LN_EPS)
    Bn, T = p.shape[:2]
    y = y.reshape(Bn, T, B_WIDTH) * ln_w.astype(F32) + ln_b.astype(F32)
    k_bonus = heads_b(0.5 * (k_eff[0] + k_eff[1]))
    bonus = jnp.sum(rh * k_bonus * heads_b(r_k.astype(F32)), -1, keepdims=True) * vh
    y = y + bonus.reshape(Bn, T, B_WIDTH)
    return y.astype(p.dtype), jnp.stack([S_f, S_b], axis=1)


def diff_attn_context(q, k, v, lam):
    s = jnp.einsum('bqhzd,bkhzd->bhzqk', q, k, preferred_element_type=F32) * (C_QK_DIM ** -0.5)
    p = jax.nn.softmax(s, -1)
    att = p[:, :, 0] - lam * p[:, :, 1]
    return jnp.einsum('bhqk,bkhd->bqhd', att.astype(v.dtype), v)


def diff_attn_latent(q, k, v, k_ctx, v_ctx, lam):
    Bn, T = q.shape[:2]
    nb = T // BLOCK
    k_all = jnp.concatenate([k_ctx, k], 1)
    v_all = jnp.concatenate([v_ctx, v], 1)
    qb = jnp.moveaxis(q.reshape(Bn, nb, BLOCK, C_HEADS, 2, C_QK_DIM), 1, 0)

    def one_block(qblk):
        s = jnp.einsum('bqhzd,bkhzd->bhzqk', qblk, k_all, preferred_element_type=F32) * (C_QK_DIM ** -0.5)
        p = jax.nn.softmax(s, -1)
        att = p[:, :, 0] - lam * p[:, :, 1]
        return jnp.einsum('bhqk,bkhd->bqhd', att.astype(v.dtype), v_all)

    o = lax.map(one_block, qb)
    return jnp.moveaxis(o, 0, 1).reshape(Bn, T, C_HEADS, C_V_DIM)


def even_layer(x, shift, scale, gate, norm_pre, norm_post, w_out, w_in, sink, mu, w0, w2, a0, a2,
               k_k, k_a, r_k, ln_w, ln_b, ctx):
    Bn, T = x.shape[:2]
    h = rms_norm(x, norm_pre) * (1.0 + scale) + shift
    qa, ka, va, ga, pb, gb = split_cols(h @ w_in, [A_WIDTH, A_KV_WIDTH, A_KV_WIDTH, A_WIDTH,
                                                    B_SHIFT_WIDTH, B_WIDTH])
    qa = qa.reshape(Bn, T, A_HEADS, HEAD_DIM)
    ka = ka.reshape(Bn, T, A_KV_HEADS, HEAD_DIM)
    va = va.reshape(Bn, T, A_KV_HEADS, HEAD_DIM)
    if ctx is None:
        ya = gqa_context(qa, ka, va, sink)
        zeros = jnp.zeros((Bn, B_HEADS, HEAD_DIM, HEAD_DIM), F32)
        yb, st = rwkv_mix(pb, zeros, zeros, mu, w0, w2, a0, a2, k_k, k_a, r_k, ln_w, ln_b)
        new = (ka, va, st)
    else:
        k_ctx, v_ctx, st0 = ctx
        cos, sin = axial_rope_tables(T, HEAD_DIM)
        ya = gqa_window_latent(apply_rope(qa, cos, sin), apply_rope(ka, cos, sin), va,
                               k_ctx, v_ctx, sink)
        yb, _ = rwkv_mix(pb, st0[:, 0], st0[:, 1], mu, w0, w2, a0, a2, k_k, k_a, r_k, ln_w, ln_b)
        new = None
    y = jnp.concatenate([ya * jax.nn.silu(ga), yb * jax.nn.silu(gb)], -1) @ w_out
    return x + gate * rms_norm(y, norm_post), new


def odd_layer(x, shift, scale, gate, norm_pre, norm_post, w_out, w_in, lq1, lk1, lq2, lk2, subln,
              lam_init, ctx):
    Bn, T = x.shape[:2]
    h = rms_norm(x, norm_pre) * (1.0 + scale) + shift
    qc, kc, vc, gc = split_cols(h @ w_in, [C_HEADS * 2 * C_QK_DIM, C_HEADS * 2 * C_QK_DIM,
                                           C_WIDTH, C_WIDTH])
    qc = qc.reshape(Bn, T, C_HEADS, 2, C_QK_DIM)
    kc = kc.reshape(Bn, T, C_HEADS, 2, C_QK_DIM)
    vc = vc.reshape(Bn, T, C_HEADS, C_V_DIM)
    lam = (jnp.exp(jnp.sum((lq1 * lk1).astype(F32))) - jnp.exp(jnp.sum((lq2 * lk2).astype(F32)))
           + lam_init)
    if ctx is None:
        o = diff_attn_context(qc, kc, vc, lam)
        new = (kc.reshape(Bn, T, C_HEADS, 2 * C_QK_DIM), vc)
    else:
        k_ctx, v_ctx = ctx
        C = k_ctx.shape[1]
        cos, sin = axial_rope_tables(T, C_QK_DIM)
        qr = apply_rope(qc.reshape(Bn, T, C_HEADS * 2, C_QK_DIM), cos, sin).reshape(qc.shape)
        kr = apply_rope(kc.reshape(Bn, T, C_HEADS * 2, C_QK_DIM), cos, sin).reshape(kc.shape)
        o = diff_attn_latent(qr, kr, vc, k_ctx.reshape(Bn, C, C_HEADS, 2, C_QK_DIM), v_ctx, lam)
        new = None
    o = rms_norm(o, subln, SUBLN_EPS) * (1.0 - lam_init)
    y = (o.reshape(Bn, T, C_WIDTH) * jax.nn.silu(gc)) @ w_out
    return x + gate * rms_norm(y, norm_post), new


def setup_inputs(seed: int = 0) -> dict:
    key = jax.random.key(seed)
    ks = jax.random.split(key, 40)

    def nrm(k, shape, s):
        return jax.random.normal(k, shape, F32) * s

    D = D_MODEL
    return {
        "x_prompt": nrm(ks[0], (BATCH, SEQ, D), 1.0),
        "x_sample": nrm(ks[1], (DEC_BATCH, DEC_SEQ, D), 1.0),
        "cache_a_k": nrm(ks[2], (DEC_BATCH, N_EVEN, PAST_LEN, A_KV_HEADS, HEAD_DIM), 1.0),
        "cache_a_v": nrm(ks[3], (DEC_BATCH, N_EVEN, PAST_LEN, A_KV_HEADS, HEAD_DIM), 1.0),
        "state_rwkv": nrm(ks[4], (DEC_BATCH, N_EVEN, 2, B_HEADS, HEAD_DIM, HEAD_DIM), 0.5),
        "cache_c_k": nrm(ks[5], (DEC_BATCH, N_ODD, PAST_LEN, C_HEADS, 2 * C_QK_DIM), 1.0),
        "cache_c_v": nrm(ks[6], (DEC_BATCH, N_ODD, PAST_LEN, C_HEADS, C_V_DIM), 1.0),
        "c": nrm(ks[7], (DEC_BATCH, D), 1.0),
        "c_ctx": nrm(ks[8], (D,), 1.0),
        "ada_w": nrm(ks[9], (DEPTH, D, 3 * D), 0.5 * D ** -0.5),
        "ada_b": nrm(ks[10], (DEPTH, 3 * D), 0.02),
        "norm_pre": 1.0 + nrm(ks[11], (DEPTH, D), 0.05),
        "norm_post": 1.0 + nrm(ks[12], (DEPTH, D), 0.05),
        "w_out": nrm(ks[13], (DEPTH, MIX_WIDTH, D), MIX_WIDTH ** -0.5),
        "even_w_in": nrm(ks[14], (N_EVEN, D, EVEN_IN), D ** -0.5),
        "a_sink": nrm(ks[15], (N_EVEN, A_HEADS), 0.5),
        "b_mu": jax.random.uniform(ks[16], (N_EVEN, B_SHIFT_WIDTH), F32),
        "b_w0": -2.0 + nrm(ks[17], (N_EVEN, 2, B_WIDTH), 0.5),
        "b_w2": nrm(ks[18], (N_EVEN, 2, DECAY_LORA, B_WIDTH), 0.1 * DECAY_LORA ** -0.5),
        "b_a0": nrm(ks[19], (N_EVEN, 2, B_WIDTH), 0.1),
        "b_a2": nrm(ks[20], (N_EVEN, 2, AAA_LORA, B_WIDTH), AAA_LORA ** -0.5),
        "b_kk": 0.85 + nrm(ks[21], (N_EVEN, B_WIDTH), 0.05),
        "b_ka": 1.0 + nrm(ks[22], (N_EVEN, B_WIDTH), 0.05),
        "b_rk": nrm(ks[23], (N_EVEN, B_WIDTH), 0.1),
        "b_ln_w": 1.0 + nrm(ks[24], (N_EVEN, B_WIDTH), 0.05),
        "b_ln_b": nrm(ks[25], (N_EVEN, B_WIDTH), 0.02),
        "odd_w_in": nrm(ks[26], (N_ODD, D, ODD_IN), D ** -0.5),
        "c_lq1": nrm(ks[27], (N_ODD, C_QK_DIM), 0.1),
        "c_lk1": nrm(ks[28], (N_ODD, C_QK_DIM), 0.1),
        "c_lq2": nrm(ks[29], (N_ODD, C_QK_DIM), 0.1),
        "c_lk2": nrm(ks[30], (N_ODD, C_QK_DIM), 0.1),
        "c_subln": 1.0 + nrm(ks[31], (N_ODD, C_V_DIM), 0.05),
    }


def reference(x_prompt, x_sample, cache_a_k, cache_a_v, state_rwkv, cache_c_k, cache_c_v, c, c_ctx,
              ada_w, ada_b, norm_pre, norm_post, w_out, even_w_in, a_sink, b_mu, b_w0, b_w2, b_a0,
              b_a2, b_kk, b_ka, b_rk, b_ln_w, b_ln_b, odd_w_in, c_lq1, c_lk1, c_lq2, c_lk2, c_subln):
    y_p, y_s = x_prompt, x_sample
    new_ak, new_av, new_st, new_ck, new_cv = [], [], [], [], []
    for layer in range(DEPTH):
        sh_c, sc_c, g_c = modulation(c_ctx, ada_w[layer], ada_b[layer])
        sh_s, sc_s, g_s = modulation(c[:, None, :], ada_w[layer], ada_b[layer])
        common = (norm_pre[layer], norm_post[layer], w_out[layer])
        if layer % 2 == 0:
            e = layer // 2
            ep = (even_w_in[e], a_sink[e], b_mu[e], b_w0[e], b_w2[e], b_a0[e], b_a2[e], b_kk[e],
                  b_ka[e], b_rk[e], b_ln_w[e], b_ln_b[e])
            y_p, (k_a, v_a, st) = even_layer(y_p, sh_c, sc_c, g_c, *common, *ep, None)
            y_s, _ = even_layer(y_s, sh_s, sc_s, g_s, *common, *ep,
                                (cache_a_k[:, e], cache_a_v[:, e], state_rwkv[:, e]))
            new_ak.append(k_a)
            new_av.append(v_a)
            new_st.append(st)
        else:
            o = layer // 2
            lam_init = 0.8 - 0.6 * math.exp(-0.3 * layer)
            op = (odd_w_in[o], c_lq1[o], c_lk1[o], c_lq2[o], c_lk2[o], c_subln[o], lam_init)
            y_p, (k_c, v_c) = odd_layer(y_p, sh_c, sc_c, g_c, *common, *op, None)
            y_s, _ = odd_layer(y_s, sh_s, sc_s, g_s, *common, *op, (cache_c_k[:, o], cache_c_v[:, o]))
            new_ck.append(k_c)
            new_cv.append(v_c)
    new_cache_a_k = jnp.stack(new_ak, axis=1)
    new_cache_a_v = jnp.stack(new_av, axis=1)
    new_state_rwkv = jnp.stack(new_st, axis=1)
    new_cache_c_k = jnp.stack(new_ck, axis=1)
    new_cache_c_v = jnp.stack(new_cv, axis=1)
    return (y_p, y_s, new_cache_a_k, new_cache_a_v, new_state_rwkv, new_cache_c_k, new_cache_c_v)
```

```cpp
#include <hip/hip_runtime.h>
#include <cstdio>
#include <cstdint>
namespace pg8 {
#define PG8_LAS __attribute__((address_space(3)))
typedef unsigned short bf16_t;
typedef short bf16x8 __attribute__((ext_vector_type(8)));
typedef float f32x4 __attribute__((ext_vector_type(4)));
typedef unsigned u32x4 __attribute__((ext_vector_type(4)));
constexpr int BM = 256, BK = 64, HALF = 128, HTB = HALF * BK * 2  , STAGE_BYTES = 8 * HTB, NXCD = 8, WGM = 8;

__host__ __device__ __forceinline__ int lds_byte(int r, int c) { const int st = (r >> 4) * 2 + (c >> 5), rr = r & 15, cc = c & 31, ob = rr * 64 + cc * 2; return st * 1024 + (ob ^ (((ob >> 9) & 1) << 5)); }
__host__ __device__ __forceinline__ void stage_rc(int b, int& R, int& C) { const int st = b / 1024, sb = b % 1024, swz = sb ^ (((sb >> 9) & 1) << 5); R = (st >> 1) * 16 + swz / 64; C = (st & 1) * 32 + (swz % 64) / 2; }
__host__ __device__ __forceinline__ int perm32(int rho) { const int n = rho >> 4, i = rho & 15; return 8 * (i >> 2) + 4 * n + (i & 3); }

struct Unit { int pm, pn; };
struct Gemm { const bf16_t* A; const bf16_t* Bt; int M, N, K; };

struct StaticOrder {
    int nM, nN, nwg, G, c;
    __host__ __device__ void init(int M, int N, int G_, int c_) { nM = M / BM; nN = N / BM; nwg = nM * nN; G = G_; c = c_; }
    __host__ __device__ bool next(int i, Unit& u) const {
        const long L = (long)i * G + c; if (L >= nwg) return false;
        int wgid = (int)L; { const int q = nwg / NXCD, r = nwg % NXCD, xcd = wgid % NXCD, off = wgid / NXCD; wgid = (xcd < r ? xcd * (q + 1) : r * (q + 1) + (xcd - r) * q) + off; }
        const int nig = WGM * nN, gid = wgid / nig, fm = gid * WGM, gsz = (nM - fm) < WGM ? (nM - fm) : WGM;
        u.pm = fm + ((wgid % nig) % gsz); u.pn = (wgid % nig) / gsz; return true;
    }
    __device__ __forceinline__ void a_ready(const Unit&) const {}
    __device__ __forceinline__ void done(const Unit&) const {}
};

__device__ __forceinline__ unsigned cvt_pk_bf16(float lo, float hi) { unsigned r; asm volatile("v_cvt_pk_bf16_f32 %0, %1, %2" : "=v"(r) : "v"(lo), "v"(hi)); return r; }
typedef float f32x2 __attribute__((ext_vector_type(2)));
struct EpiF32 {
    static constexpr bool PERM = false, AFTER_DRAIN = false;
    float* C; int ldc;
    __device__ __forceinline__ void operator()(const f32x4 (&acc)[2][2][4][2], const Unit& u, int wr, int wc, int fr, int fq) const {
        const int row0 = u.pm * BM + wr * 64 + fr, col0 = u.pn * BM + wc * 32 + 4 * fq;
#pragma unroll
        for (int ai = 0; ai < 2; ++ai)
#pragma unroll
            for (int m = 0; m < 4; ++m) { float* rowp = C + (size_t)(row0 + ai * HALF + m * 16) * ldc + col0;
#pragma unroll
                for (int bj = 0; bj < 2; ++bj)
#pragma unroll
                    for (int n = 0; n < 2; ++n) *(f32x4*)(rowp + bj * HALF + n * 16) = acc[ai][bj][m][n]; }
    }
};
struct EpiIn {
    static constexpr bool PERM = true, AFTER_DRAIN = false;
    bf16_t* O; int ldc; int nvalid; int rope_cols; const float* rope;
    float* out_k; float* out_v; int ck0, ck1, cv0, cv1, cpk, cpv;
    __device__ __forceinline__ void operator()(const f32x4 (&acc)[2][2][4][2], const Unit& u, int wr, int wc, int fr, int fq) const {
#pragma unroll
        for (int bj = 0; bj < 2; ++bj) {
            const int colbase = u.pn * BM + bj * HALF;
            if (colbase >= nvalid) continue;
            const int col0 = colbase + wc * 32 + 8 * fq;
            const bool dorope = (u.pm >= 32) && (colbase < rope_cols);
            const bool isk = (u.pm < 32) && (colbase >= ck0) && (colbase < ck1);
            const bool isv = (u.pm < 32) && (colbase >= cv0) && (colbase < cv1);
#pragma unroll
            for (int ai = 0; ai < 2; ++ai)
#pragma unroll
                for (int m = 0; m < 4; ++m) {
                    const int row = u.pm * BM + ai * HALF + wr * 64 + m * 16 + fr;
                    f32x4 v0 = acc[ai][bj][m][0], v1 = acc[ai][bj][m][1];
                    if (dorope) {
                        const int t = (row - 8192) & 2047; const int pos = (wc & 1) ? (t & 63) : (t >> 6);
                        const float* cs = rope + (pos * 16 + 8 * (fq & 1)) * 2;
                        const float sg = (fq < 2) ? -1.f : 1.f;
                        f32x4 p0, p1;
#pragma unroll
                        for (int i = 0; i < 4; ++i) { p0[i] = __shfl_xor(v0[i], 32); p1[i] = __shfl_xor(v1[i], 32); }
                        const f32x4 c0 = *(const f32x4*)(cs), c1 = *(const f32x4*)(cs + 4), c2 = *(const f32x4*)(cs + 8), c3 = *(const f32x4*)(cs + 12);
                        v0[0] = v0[0] * c0[0] + sg * p0[0] * c0[1]; v0[1] = v0[1] * c0[2] + sg * p0[1] * c0[3];
                        v0[2] = v0[2] * c1[0] + sg * p0[2] * c1[1]; v0[3] = v0[3] * c1[2] + sg * p0[3] * c1[3];
                        v1[0] = v1[0] * c2[0] + sg * p1[0] * c2[1]; v1[1] = v1[1] * c2[2] + sg * p1[1] * c2[3];
                        v1[2] = v1[2] * c3[0] + sg * p1[2] * c3[1]; v1[3] = v1[3] * c3[2] + sg * p1[3] * c3[3];
                    }
                    u32x4 w; w.x = cvt_pk_bf16(v0[0], v0[1]); w.y = cvt_pk_bf16(v0[2], v0[3]); w.z = cvt_pk_bf16(v1[0], v1[1]); w.w = cvt_pk_bf16(v1[2], v1[3]);
                    *(u32x4*)(O + (size_t)row * ldc + col0) = w;
                    if (isk) { float* p = out_k + (size_t)row * cpk + (col0 - ck0); *(f32x4*)p = v0; *(f32x4*)(p + 4) = v1; }
                    if (isv) { float* p = out_v + (size_t)row * cpv + (col0 - cv0); *(f32x4*)p = v0; *(f32x4*)(p + 4) = v1; }
                }
        }
    }
};
template <class Epi, class Sched, bool ALIGN_EPI = false, bool SP2 = false>
__device__ __forceinline__ void gemm_phase(PG8_LAS unsigned char* lds, const Gemm g, const Sched& S, const Epi& E) {
    const int tid = threadIdx.x, wid = __builtin_amdgcn_readfirstlane(tid >> 6), lane = tid & 63, wr = wid >> 2, wc = wid & 3, fr = lane & 15, fq = lane >> 4;
    const int K = g.K, nt = K / BK;
    unsigned voffA[2], voffB[2];
#pragma unroll
    for (int i = 0; i < 2; ++i) { int R, C; stage_rc(tid * 16 + i * 8192, R, C); const int Rb = Epi::PERM ? ((R & ~31) + perm32(R & 31)) : R;
        voffA[i] = (unsigned)(R * K + C) * 2u; voffB[i] = (unsigned)(Rb * K + C) * 2u; }
    const size_t kstep = (size_t)(BK * 2);
    const size_t hstep = (size_t)HALF * K * 2;
    const size_t tstep = 2 * hstep;
    const unsigned ldsw = (unsigned)wid * 1024u;
    const int aoff = lds_byte(wr * 64 + fr, fq * 8), boff = lds_byte(wc * 32 + fr, fq * 8);
#define PG8_SA(b, h) (((b) * 2 + (h)) * HTB)
#define PG8_SB(b, h) ((4 + (b) * 2 + (h)) * HTB)
#define PG8_STAGE(bufoff, gbase, voff) do { _Pragma("unroll") for (int _i = 0; _i < 2; ++_i) \
        __builtin_amdgcn_global_load_lds((const unsigned*)((const char*)(gbase) + (voff)[_i]), (PG8_LAS unsigned*)(lds + (bufoff) + ldsw + _i * 8192), 16, 0, 0); } while (0)
#define PG8_LDA(dst, b, h) do { _Pragma("unroll") for (int m = 0; m < 4; ++m) _Pragma("unroll") for (int k = 0; k < 2; ++k) dst[m][k] = *(const PG8_LAS bf16x8*)(lds + PG8_SA(b, h) + aoff + m * 2048 + k * 1024); } while (0)
#define PG8_LDB(dst, b, h) do { _Pragma("unroll") for (int n = 0; n < 2; ++n) _Pragma("unroll") for (int k = 0; k < 2; ++k) dst[n][k] = *(const PG8_LAS bf16x8*)(lds + PG8_SB(b, h) + boff + n * 2048 + k * 1024); } while (0)
#define PG8_MMA(ai, bj, At, Bt) do { __builtin_amdgcn_s_setprio(1); _Pragma("unroll") for (int m = 0; m < 4; ++m) _Pragma("unroll") for (int n = 0; n < 2; ++n) _Pragma("unroll") for (int k = 0; k < 2; ++k) \
        acc[ai][bj][m][n] = __builtin_amdgcn_mfma_f32_16x16x32_bf16(Bt[n][k], At[m][k], acc[ai][bj][m][n], 0, 0, 0); __builtin_amdgcn_s_setprio(0); } while (0)
#define PG8_WAIT_V(n) asm volatile("s_waitcnt vmcnt(" #n ")" ::: "memory")
#define PG8_WAIT_L(n) asm volatile("s_waitcnt lgkmcnt(" #n ")" ::: "memory")
#define PG8_BAR __builtin_amdgcn_s_barrier()
#define PG8_SCHED __builtin_amdgcn_sched_barrier(0)
    Unit cur, nxt; int ui = 0;
    if (!S.next(0, cur)) return;
    f32x4 acc[2][2][4][2];
#pragma unroll
    for (int a = 0; a < 2; ++a)
#pragma unroll
        for (int b = 0; b < 2; ++b)
#pragma unroll
            for (int m = 0; m < 4; ++m)
#pragma unroll
                for (int n = 0; n < 2; ++n) acc[a][b][m][n] = (f32x4){0.f, 0.f, 0.f, 0.f};
    bf16x8 At[4][2], B0[2][2], B1[2][2];
    const char* cA = (const char*)g.A + (size_t)cur.pm * tstep; const char* cB = (const char*)g.Bt + (size_t)cur.pn * tstep;
    S.a_ready(cur);
    if constexpr (SP2) {
        PG8_STAGE(PG8_SB(0, 0), cB, voffB); PG8_STAGE(PG8_SB(0, 1), cB + hstep, voffB); PG8_STAGE(PG8_SA(0, 0), cA, voffA); PG8_STAGE(PG8_SA(0, 1), cA + hstep, voffA);
        if (wr == 1) PG8_BAR;
        PG8_WAIT_V(2); PG8_BAR;
        PG8_STAGE(PG8_SB(1, 0), cB + kstep, voffB); PG8_STAGE(PG8_SA(1, 0), cA + kstep, voffA); PG8_STAGE(PG8_SB(1, 1), cB + hstep + kstep, voffB);
        PG8_WAIT_V(6); PG8_BAR;
    } else {
        PG8_STAGE(PG8_SB(0, 0), cB, voffB); PG8_STAGE(PG8_SA(0, 0), cA, voffA); PG8_STAGE(PG8_SB(0, 1), cB + hstep, voffB); PG8_STAGE(PG8_SA(0, 1), cA + hstep, voffA);
        if (wr == 1) PG8_BAR;
        PG8_WAIT_V(4); PG8_BAR;
        PG8_STAGE(PG8_SB(1, 0), cB + kstep, voffB); PG8_STAGE(PG8_SA(1, 0), cA + kstep, voffA); PG8_STAGE(PG8_SB(1, 1), cB + hstep + kstep, voffB);
        PG8_WAIT_V(6); PG8_BAR;
    }
    for (;;) {
        const bool has_next = S.next(ui + 1, nxt);
        const char* nA = has_next ? (const char*)g.A + (size_t)nxt.pm * tstep : cA; const char* nB = has_next ? (const char*)g.Bt + (size_t)nxt.pn * tstep : cB;
        for (int t = 0; t < nt; t += 2) {
            const bool last = (t == nt - 2);
            const char* a1 = cA + (size_t)(t + 1) * kstep;
            const char* a2 = last ? nA : cA + (size_t)(t + 2) * kstep; const char* b2 = last ? nB : cB + (size_t)(t + 2) * kstep;
            const char* a3 = a2 + kstep; const char* b3 = b2 + kstep;
            if (last && has_next) S.a_ready(nxt);
            if constexpr (SP2) {
            PG8_LDB(B0, 0, 0); PG8_LDB(B1, 0, 1); PG8_SCHED; PG8_LDA(At, 0, 0); PG8_STAGE(PG8_SA(1, 1), a1 + hstep, voffA);
            PG8_WAIT_V(8); PG8_WAIT_L(0); PG8_BAR; PG8_MMA(0, 0, At, B0); PG8_MMA(0, 1, At, B1); PG8_BAR; PG8_SCHED;
            PG8_LDA(At, 0, 1); PG8_STAGE(PG8_SB(0, 0), b2, voffB); PG8_STAGE(PG8_SB(0, 1), b2 + hstep, voffB); PG8_STAGE(PG8_SA(0, 0), a2, voffA);
            PG8_WAIT_V(8); PG8_WAIT_L(0); PG8_BAR; PG8_MMA(1, 0, At, B0); PG8_MMA(1, 1, At, B1); PG8_BAR; PG8_SCHED;
            PG8_LDB(B0, 1, 0); PG8_LDB(B1, 1, 1); PG8_SCHED; PG8_LDA(At, 1, 0); PG8_STAGE(PG8_SA(0, 1), a2 + hstep, voffA);
            PG8_WAIT_V(8); PG8_WAIT_L(0); PG8_BAR; PG8_MMA(0, 0, At, B0); PG8_MMA(0, 1, At, B1); PG8_BAR; PG8_SCHED;
            PG8_LDA(At, 1, 1); PG8_STAGE(PG8_SB(1, 0), b3, voffB); PG8_STAGE(PG8_SB(1, 1), b3 + hstep, voffB); PG8_STAGE(PG8_SA(1, 0), a3, voffA);
            PG8_WAIT_V(8); PG8_WAIT_L(0); PG8_BAR; PG8_MMA(1, 0, At, B0); PG8_MMA(1, 1, At, B1); PG8_BAR; PG8_SCHED;
            } else {
            PG8_LDB(B0, 0, 0); PG8_SCHED; PG8_LDA(At, 0, 0); PG8_STAGE(PG8_SA(1, 1), a1 + hstep, voffA);
            PG8_WAIT_L(8); PG8_BAR; PG8_WAIT_L(0); PG8_MMA(0, 0, At, B0); PG8_BAR; PG8_SCHED;
            PG8_LDB(B1, 0, 1); PG8_STAGE(PG8_SB(0, 0), b2, voffB);
            PG8_BAR; PG8_WAIT_L(0); PG8_MMA(0, 1, At, B1); PG8_BAR;
            PG8_LDA(At, 0, 1); PG8_STAGE(PG8_SA(0, 0), a2, voffA);
            PG8_BAR; PG8_WAIT_L(0); PG8_MMA(1, 0, At, B0); PG8_BAR; PG8_SCHED;
            PG8_STAGE(PG8_SB(0, 1), b2 + hstep, voffB);
            PG8_WAIT_V(6); PG8_BAR; PG8_MMA(1, 1, At, B1); PG8_BAR;
            PG8_LDB(B0, 1, 0); PG8_SCHED; PG8_LDA(At, 1, 0); PG8_STAGE(PG8_SA(0, 1), a2 + hstep, voffA);
            PG8_WAIT_L(8); PG8_BAR; PG8_WAIT_L(0); PG8_MMA(0, 0, At, B0); PG8_BAR; PG8_SCHED;
            PG8_LDB(B1, 1, 1); PG8_STAGE(PG8_SB(1, 0), b3, voffB);
            PG8_BAR; PG8_WAIT_L(0); PG8_MMA(0, 1, At, B1); PG8_BAR;
            PG8_LDA(At, 1, 1); PG8_STAGE(PG8_SA(1, 0), a3, voffA);
            PG8_BAR; PG8_WAIT_L(0); PG8_MMA(1, 0, At, B0); PG8_BAR; PG8_SCHED;
            PG8_STAGE(PG8_SB(1, 1), b3 + hstep, voffB);
            PG8_WAIT_V(6); PG8_BAR; PG8_MMA(1, 1, At, B1); PG8_BAR;
            }
        }
        if constexpr (ALIGN_EPI) { if (wr == 0) PG8_BAR; }
        if constexpr (!Epi::AFTER_DRAIN) { E(acc, cur, wr, wc, fr, fq); S.done(cur); }
        if (!has_next) break;
#pragma unroll
        for (int a = 0; a < 2; ++a)
#pragma unroll
            for (int b = 0; b < 2; ++b)
#pragma unroll
                for (int m = 0; m < 4; ++m)
#pragma unroll
                    for (int n = 0; n < 2; ++n) acc[a][b][m][n] = (f32x4){0.f, 0.f, 0.f, 0.f};
        cur = nxt; cA = nA; cB = nB; ++ui;
        if constexpr (ALIGN_EPI) { if (wr == 1) PG8_BAR; }
    }
    PG8_WAIT_V(0);
    if constexpr (!ALIGN_EPI) { if (wr == 0) PG8_BAR; }
    PG8_BAR;
    if constexpr (Epi::AFTER_DRAIN) { E.fused(acc, cur, wr, wc, fr, fq, lds, wid, lane); S.done(cur); }
#undef PG8_SA
#undef PG8_SB
#undef PG8_STAGE
#undef PG8_LDA
#undef PG8_LDB
#undef PG8_MMA
#undef PG8_WAIT_V
#undef PG8_WAIT_L
#undef PG8_BAR
#undef PG8_SCHED
}
}
#define GAS __attribute__((address_space(1)))
#define LAS __attribute__((address_space(3)))
typedef unsigned short bf16;
typedef unsigned v4u __attribute__((ext_vector_type(4)));
typedef float f32x4 __attribute__((ext_vector_type(4)));
typedef short bf16x8 __attribute__((ext_vector_type(8)));
typedef GAS unsigned gu32;
typedef GAS unsigned long long gu64;
#define RLX_AGENT __ATOMIC_RELAXED, __HIP_MEMORY_SCOPE_AGENT
#define LDS_WAIT() asm volatile("s_waitcnt lgkmcnt(0)" ::: "memory")
#define VM_WAIT() asm volatile("s_waitcnt vmcnt(0)" ::: "memory")
__device__ __forceinline__ unsigned long long rt() { return __builtin_amdgcn_s_memrealtime(); }
__device__ __forceinline__ unsigned f2bf(float f) { unsigned u = __builtin_bit_cast(unsigned, f); return (u + 0x7fffu + ((u >> 16) & 1u)) >> 16; }
__device__ __forceinline__ unsigned pk2(float lo, float hi) { return f2bf(lo) | (f2bf(hi) << 16); }

#define XB_TMO      128
#define XB_XCNT(j)  (256  + 64 * (j))
#define XB_XSUB(j)  (1280 + 64 * (j))
#define XB_XGEN(j)  (2304 + 64 * (j))
#define XB_TOP      3328
#define XB_TOPGEN   3392
#define XCD_BAR_WORDS 3456
#define XB_SPIN_CAP (1u << 18)

__device__ __forceinline__ unsigned xb_ld(unsigned* p)              { return __hip_atomic_load(p, __ATOMIC_RELAXED, __HIP_MEMORY_SCOPE_AGENT); }
__device__ __forceinline__ unsigned xb_add(unsigned* p, unsigned v) { return __hip_atomic_fetch_add(p, v, __ATOMIC_RELAXED, __HIP_MEMORY_SCOPE_AGENT); }
__device__ __forceinline__ unsigned xb_xcc_id() { return (unsigned)__builtin_amdgcn_s_getreg((3 << 11) | 20) & 0xFu; }
#define XB_SPIN(cond, bar) do { unsigned _sp = 0; while (cond) { __builtin_amdgcn_s_sleep(1); \
    if ((++_sp & 255u) == 0u) { if (xb_ld(&(bar)[XB_TMO])) break; if (_sp > XB_SPIN_CAP) { atomicAdd(&(bar)[XB_TMO], 1u); break; } } } } while (0)

struct XcdBarrier {
    unsigned* bar; unsigned x;
    volatile LAS unsigned* st;
};

__device__ __forceinline__ XcdBarrier xcd_barrier_post(unsigned* bar, volatile LAS unsigned* st) {
    XcdBarrier b; b.bar = bar; b.x = xb_xcc_id(); b.st = st;
    if (threadIdx.x == 0) (void)xb_add(&bar[XB_XCNT(b.x)], 1u);
    return b;
}
__device__ __forceinline__ void xcd_barrier_complete(unsigned* bar, unsigned x, unsigned& nloc, unsigned& nx) {
    const unsigned G = gridDim.x * gridDim.y * gridDim.z;
    unsigned sum, cnt, mine, sp = 0u;
    for (;;) {
        sum = 0u; cnt = 0u; mine = 0u;
#pragma unroll
        for (unsigned j = 0; j < 16; ++j) { const unsigned c = xb_ld(&bar[XB_XCNT(j)]); sum += c; cnt += (c > 0u) ? 1u : 0u; mine = (j == x) ? c : mine; }
        if (sum == G) break;
        __builtin_amdgcn_s_sleep(1);
        if ((++sp & 255u) == 0u) { if (xb_ld(&bar[XB_TMO])) break; if (sp > XB_SPIN_CAP) { atomicAdd(&bar[XB_TMO], 1u); break; } }
    }
    nloc = mine > 0u ? mine : 1u; nx = cnt > 0u ? cnt : 1u;
}

__device__ __forceinline__ void xcd_barrier(const XcdBarrier& b) {
    asm volatile("s_waitcnt vmcnt(0)" ::: "memory");
    __syncthreads();
    if (threadIdx.x == 0) {
        unsigned* bar = b.bar;
        __builtin_amdgcn_s_waitcnt(0);
        unsigned nloc = b.st[0], nx = b.st[1];
        if (nloc == 0u) { xcd_barrier_complete(bar, b.x, nloc, nx); b.st[0] = nloc; b.st[1] = nx; }
        const unsigned old = xb_add(&bar[XB_XSUB(b.x)], 1u);
        const unsigned gen = old / nloc;
        if (old + 1u == (gen + 1u) * nloc) {
            __builtin_amdgcn_fence(__ATOMIC_RELEASE, "agent");
            asm volatile("s_waitcnt vmcnt(0)" ::: "memory");
            const unsigned og = xb_add(&bar[XB_TOP], 1u);
            const unsigned tg = og / nx;
            if (og + 1u == (tg + 1u) * nx) xb_add(&bar[XB_TOPGEN], 1u);
            else XB_SPIN(xb_ld(&bar[XB_TOPGEN]) == tg, bar);
            __builtin_amdgcn_fence(__ATOMIC_ACQUIRE, "agent");
            xb_add(&bar[XB_XGEN(b.x)], 1u);
            asm volatile("s_waitcnt vmcnt(0)" ::: "memory");
        } else {
            XB_SPIN(xb_ld(&bar[XB_XGEN(b.x)]) == gen, bar);
            __builtin_amdgcn_fence(__ATOMIC_ACQUIRE, "agent");
            asm volatile("s_waitcnt vmcnt(0)" ::: "memory");
        }
    }
    __syncthreads();
}
constexpr int NWAVES = 8;
constexpr int D = 1024, MP = 8192, MS = 4096, M = MP + MS;
constexpr int N0 = 3456, N0P = 3584, N1 = 4096;
constexpr float NORM_EPS = 1e-6f;
constexpr size_t OUT_Y = 0, OUT_AK = 12582912, OUT_AV = 13631488, OUT_ST = 14680064, OUT_CK = 16777216, OUT_CV = 25165824;
constexpr size_t MiB = 1u << 20;
constexpr size_t WS_CTL = 0, CTL_ZERO_BYTES = 64 * 1024;
constexpr size_t WS_WT0 = 2 * MiB, WS_WO0 = 9 * MiB, WS_WT1 = 11 * MiB, WS_WO1 = 19 * MiB;
constexpr size_t WS_MODP = 21 * MiB, WS_ROPE = 22 * MiB;
constexpr size_t WS_CAK = 23 * MiB, WS_CAV = WS_CAK + 131072, WS_CCK = WS_CAV + 131072, WS_CCV = WS_CCK + MiB;
constexpr size_t WS_BONUS = 26 * MiB, WS_XN = 27 * MiB, WS_MIX = 51 * MiB, WS_PROJ = 75 * MiB, WS_Y = 171 * MiB, WS_YF = 171 * MiB, WS_YB = 195 * MiB, WS_END = 219 * MiB;
constexpr int CW_BAR = 4096;
constexpr int RING_BYTES = 131072, LDSCTL_OFF = RING_BYTES, MISC_OFF = LDSCTL_OFF + 320, LDS_BYTES = 147456;

struct Params { const float* in[32]; float* out; unsigned char* ws; int ph_lo, ph_hi; };
enum { I_XP = 0, I_XS, I_CAK, I_CAV, I_ST, I_CCK, I_CCV, I_C, I_CCTX, I_ADAW, I_ADAB, I_NPRE, I_NPOST, I_WOUT, I_EWIN, I_SINK, I_MU, I_W0, I_W2, I_A0, I_A2, I_KK, I_KA, I_RK,
       I_LNW, I_LNB, I_OWIN, I_LQ1, I_LK1, I_LQ2, I_LK2, I_SUBLN };

__device__ __forceinline__ float wave_sum(float v) {
#pragma unroll
    for (int o = 1; o < 64; o <<= 1) v += __shfl_xor(v, o);
    return v;
}
__device__ __forceinline__ float silu_f(float x) { return x / (1.f + __expf(-x)); }
__device__ __forceinline__ const float* xrow(const Params& P, int r) { return r < MP ? P.in[I_XP] + (size_t)r * D : P.in[I_XS] + (size_t)(r - MP) * D; }
__device__ __forceinline__ int modidx(int r) { return r < MP ? 0 : 1 + ((r - MP) >> 11); }

__device__ __forceinline__ void p0_transpose_item(const float* W, int K, int N, bf16* WT, LAS float* scr, int item, int lane) {
    const int nblk = N / 32, kb = item / nblk, nb = item % nblk, k0 = 64 * kb, n0 = 32 * nb;
#pragma unroll 8
    for (int i = 0; i < 32; ++i) { const int kk = 2 * i + (lane >> 5); scr[kk * 33 + (lane & 31)] = W[(size_t)(k0 + kk) * N + n0 + (lane & 31)]; }
    LDS_WAIT(); asm volatile("" ::: "memory");
    const int c = lane & 7;
#pragma unroll
    for (int j = 0; j < 4; ++j) { const int n = (lane >> 3) + 8 * j; const LAS float* s = scr + (8 * c) * 33 + n;
        v4u o; o.x = pk2(s[0 * 33], s[1 * 33]); o.y = pk2(s[2 * 33], s[3 * 33]); o.z = pk2(s[4 * 33], s[5 * 33]); o.w = pk2(s[6 * 33], s[7 * 33]);
        *(GAS v4u*)(WT + (size_t)(n0 + n) * K + k0 + 8 * c) = o; }
    LDS_WAIT(); asm volatile("" ::: "memory");
}
__device__ __forceinline__ float mod_val(const Params& P, int l, int j, int n) {
    const float* mp = (const float*)(P.ws + WS_MODP);
    float s = P.in[I_ADAB][l * 3072 + n];
#pragma unroll
    for (int kc = 0; kc < 8; ++kc) s += mp[((l * 8 + kc) * 3 + j) * 3072 + n];
    return s;
}

__device__ __forceinline__ void p0_prologue(const Params& P, LAS unsigned char* lds, int G, int vcu, int wave, int lane, int tid) {
    LAS float* scr = (LAS float*)(lds + wave * 16384);
    const int gw = vcu * NWAVES + wave, NGW = G * NWAVES;
    constexpr int I_T0 = 16 * (N0 / 32), I_TO = 16 * 32, I_T1 = 16 * (N1 / 32), I_MOD = 2 * 8 * 48;
    constexpr int NITEMS = I_T0 + 2 * I_TO + I_T1 + I_MOD;
    for (int it = gw; it < NITEMS; it += NGW) {
        int r = it;
        if (r < I_MOD) {
            const int l = r / 384, rem = r % 384, kc = rem / 48, nb = rem % 48, n = nb * 64 + lane, k0 = kc * 128;
            const float* W = P.in[I_ADAW] + ((size_t)l * 1024 + k0) * 3072 + n;
            const float* c0p = P.in[I_CCTX] + k0; const float* c1p = P.in[I_C] + k0; const float* c2p = P.in[I_C] + 1024 + k0;
            float a0 = 0.f, a1 = 0.f, a2 = 0.f;
#pragma unroll 8
            for (int kk = 0; kk < 128; ++kk) { const float w = W[(size_t)kk * 3072];
                a0 += silu_f(c0p[kk]) * w; a1 += silu_f(c1p[kk]) * w; a2 += silu_f(c2p[kk]) * w; }
            float* mp = (float*)(P.ws + WS_MODP) + (size_t)((l * 8 + kc) * 3) * 3072 + n;
            mp[0] = a0; mp[3072] = a1; mp[6144] = a2;
            continue; }
        r -= I_MOD;
        if (r < I_T0) { p0_transpose_item(P.in[I_EWIN], D, N0, (bf16*)(P.ws + WS_WT0), scr, r, lane); continue; } r -= I_T0;
        if (r < I_TO) { p0_transpose_item(P.in[I_WOUT], D, D, (bf16*)(P.ws + WS_WO0), scr, r, lane); continue; } r -= I_TO;
        if (r < I_TO) { p0_transpose_item(P.in[I_WOUT] + (size_t)D * D, D, D, (bf16*)(P.ws + WS_WO1), scr, r, lane); continue; } r -= I_TO;
        p0_transpose_item(P.in[I_OWIN], D, N1, (bf16*)(P.ws + WS_WT1), scr, r, lane);
    }
    const int gt = vcu * 512 + tid, NT = G * 512;
    { unsigned* z = (unsigned*)(P.ws + WS_WT0 + (size_t)N0 * D * 2); for (int i = gt; i < 128 * D / 2; i += NT) z[i] = 0u; }
    { const float* s0 = P.in[I_CAK]; const float* s1 = P.in[I_CAV]; const float* s2 = P.in[I_CCK]; const float* s3 = P.in[I_CCV];
      unsigned* d0 = (unsigned*)(P.ws + WS_CAK); unsigned* d1 = (unsigned*)(P.ws + WS_CAV); unsigned* d2 = (unsigned*)(P.ws + WS_CCK); unsigned* d3 = (unsigned*)(P.ws + WS_CCV);
      for (int i = gt; i < 32768; i += NT) { d0[i] = pk2(s0[2 * i], s0[2 * i + 1]); d1[i] = pk2(s1[2 * i], s1[2 * i + 1]); }
      for (int i = gt; i < 262144; i += NT) { d2[i] = pk2(s2[2 * i], s2[2 * i + 1]); d3[i] = pk2(s3[2 * i], s3[2 * i + 1]); } }
    { float* rt_ = (float*)(P.ws + WS_ROPE); for (int i = gt; i < 1024; i += NT) { const int pos = i >> 4, f = i & 15;
        const float inv = 1.0f / powf(10000.0f, (float)f / 16.0f); const float ang = (float)pos * inv; float sn, cs; sincosf(ang, &sn, &cs); rt_[2 * i] = cs; rt_[2 * i + 1] = sn; } }
}

__device__ __forceinline__ void p1_hprep(const Params& P, LAS unsigned char* lds, int G, int vcu, int wave, int lane, int tid) {
    LAS float* gs = (LAS float*)lds; LAS float* sh = gs + 3 * 1024;
    for (int i = tid; i < 3 * 1024; i += 512) { const int j = i >> 10, k = i & 1023;
        gs[i] = P.in[I_NPRE][k] * (1.f + mod_val(P, 0, j, 1024 + k)); sh[i] = mod_val(P, 0, j, k); }
    __syncthreads();
    const int gw = vcu * NWAVES + wave, NGW = G * NWAVES;
    bf16* XN = (bf16*)(P.ws + WS_XN);
    for (int r = gw; r < M; r += NGW) {
        const f32x4* xr = (const f32x4*)xrow(P, r) + lane; const int j = modidx(r);
        f32x4 v[4]; float s = 0.f;
#pragma unroll
        for (int q = 0; q < 4; ++q) { v[q] = xr[64 * q]; s += (v[q].x * v[q].x + v[q].y * v[q].y) + (v[q].z * v[q].z + v[q].w * v[q].w); }
        const float rinv = 1.f / sqrtf(wave_sum(s) * (1.f / D) + NORM_EPS);
        unsigned long long* o8 = (unsigned long long*)(XN + (size_t)r * D) + lane;
#pragma unroll
        for (int q = 0; q < 4; ++q) { const int k = 256 * q + 4 * lane; const LAS float* g = gs + j * 1024 + k; const LAS float* b = sh + j * 1024 + k;
            const float o0 = v[q].x * rinv * g[0] + b[0], o1 = v[q].y * rinv * g[1] + b[1], o2 = v[q].z * rinv * g[2] + b[2], o3 = v[q].w * rinv * g[3] + b[3];
            o8[64 * q] = (unsigned long long)pk2(o0, o1) | ((unsigned long long)pk2(o2, o3) << 32); }
    }
    __syncthreads();
}
namespace att {
using bf16x8 = __attribute__((ext_vector_type(8))) short;
using s16x4  = __attribute__((ext_vector_type(4))) short;
using f32x16 = __attribute__((ext_vector_type(16))) float;
using u32x4  = __attribute__((ext_vector_type(4))) unsigned;
constexpr float SCALE = 0.125f, CSC = 0.125f * 1.4426950408889634f, THR = 8.f;
#define ATT_SBAR() __builtin_amdgcn_sched_barrier(0)
__device__ __forceinline__ int crow(int r, int hi) { return (r & 3) + 8 * (r >> 2) + 4 * hi; }
__device__ __forceinline__ unsigned cvtpk(float lo, float hi) { unsigned r; asm volatile("v_cvt_pk_bf16_f32 %0, %1, %2" : "=v"(r) : "v"(lo), "v"(hi)); return r; }
__device__ __forceinline__ void partialSM(f32x16& p0, f32x16& p1, float& m_reg, float& alpha) {
  float pmax = p0[0];
#pragma unroll
  for (int r = 1; r < 16; ++r) pmax = fmaxf(pmax, p0[r]);
#pragma unroll
  for (int r = 0; r < 16; ++r) pmax = fmaxf(pmax, p1[r]);
  { auto rr = __builtin_amdgcn_permlane32_swap(__float_as_uint(pmax), __float_as_uint(pmax), false, false);
    pmax = fmaxf(__uint_as_float(rr[0]), __uint_as_float(rr[1])); }
  float mn;
  if (__builtin_expect(__all(pmax - m_reg <= THR / SCALE), 1)) { mn = m_reg; alpha = 1.f; }
  else { mn = fmaxf(m_reg, pmax); alpha = __builtin_amdgcn_exp2f((m_reg - mn) * CSC); m_reg = mn; }
  const float mnC = -mn * CSC;
#pragma unroll
  for (int r = 0; r < 16; ++r) p0[r] = fmaf(p0[r], CSC, mnC);
#pragma unroll
  for (int r = 0; r < 16; ++r) p1[r] = fmaf(p1[r], CSC, mnC);
#pragma unroll
  for (int r = 0; r < 16; ++r) p0[r] = __builtin_amdgcn_exp2f(p0[r]);
}
__device__ __forceinline__ void finishSM(f32x16& p0, f32x16& p1, float alpha, float& l_reg, bf16x8& pa0, bf16x8& pa1, bf16x8& pa2, bf16x8& pa3) {
#pragma unroll
  for (int r = 0; r < 16; ++r) p1[r] = __builtin_amdgcn_exp2f(p1[r]);
  float ps = 0;
#pragma unroll
  for (int r = 0; r < 16; ++r) ps += p0[r];
#pragma unroll
  for (int r = 0; r < 16; ++r) ps += p1[r];
  { auto rr = __builtin_amdgcn_permlane32_swap(__float_as_uint(ps), __float_as_uint(ps), false, false);
    ps = __uint_as_float(rr[0]) + __uint_as_float(rr[1]); }
  l_reg = l_reg * alpha + ps;
#define PK4(P, BASE, OUT) do { unsigned a0 = cvtpk(P[BASE + 0], P[BASE + 1]), a1 = cvtpk(P[BASE + 2], P[BASE + 3]);   \
    unsigned b0 = cvtpk(P[BASE + 4], P[BASE + 5]), b1 = cvtpk(P[BASE + 6], P[BASE + 7]);                              \
    auto r0 = __builtin_amdgcn_permlane32_swap(a0, b0, false, false); auto r1 = __builtin_amdgcn_permlane32_swap(a1, b1, false, false); \
    u32x4 w = {r0[0], r1[0], r0[1], r1[1]}; OUT = *reinterpret_cast<bf16x8*>(&w); } while (0)
  PK4(p0, 0, pa0); PK4(p0, 8, pa1); PK4(p1, 0, pa2); PK4(p1, 8, pa3);
#undef PK4
}
template <int KW> __device__ __forceinline__ int kswz(int row, int colB) { return row * (KW * 2) + (colB ^ ((row & 7) << 4)); }
template <int KW> __device__ __forceinline__ void qkt(f32x16& p0, f32x16& p1, const LAS unsigned char* Ks, int kcolB, const bf16x8* qr, int r32, int hi) {
  p0 = f32x16{}; p1 = f32x16{};
#pragma unroll
  for (int d0 = 0; d0 < 4; ++d0) { const int cb = kcolB + (d0 * 16 + hi * 8) * 2;
    const bf16x8 b0 = *(const LAS bf16x8*)(Ks + kswz<KW>(r32, cb));
    const bf16x8 b1 = *(const LAS bf16x8*)(Ks + kswz<KW>(32 + r32, cb));
    p0 = __builtin_amdgcn_mfma_f32_32x32x16_bf16(b0, qr[d0], p0, 0, 0, 0);
    p1 = __builtin_amdgcn_mfma_f32_32x32x16_bf16(b1, qr[d0], p1, 0, 0, 0); }
}
template <int NCB> __device__ __forceinline__ int v_st(int k, int c) { const int kk = (k & ~0xC) | ((k & 4) << 1) | ((k & 8) >> 1); return ((kk >> 3) * NCB + (c >> 5)) * 512 + ((kk & 7) * 32 + (c & 31)) * 2; }
__device__ __forceinline__ int v_rd_base(int lane) { return ((lane & 3) << 3) | (((lane >> 2) & 3) << 6) | (((lane >> 4) & 1) << 5) | (((lane >> 5) & 1) << 8); }
template <int NCB> constexpr int v_rd_off(int d0, int ks, int half) { return d0 * 512 + ks * (2 * NCB * 512) + half * (NCB * 512); }
template <int OFF> __device__ __forceinline__ s16x4 tr_read(int vb) { s16x4 r; asm volatile("ds_read_b64_tr_b16 %0, %1 offset:%2" : "=&v"(r) : "v"(vb), "i"(OFF) : "memory"); return r; }
template <int NCB, int D0> __device__ __forceinline__ void pv_one(f32x16& od, int vb, bf16x8 pa0, bf16x8 pa1, bf16x8 pa2, bf16x8 pa3) {
  const s16x4 l0 = tr_read<v_rd_off<NCB>(D0, 0, 0)>(vb), h0 = tr_read<v_rd_off<NCB>(D0, 0, 1)>(vb), l1 = tr_read<v_rd_off<NCB>(D0, 1, 0)>(vb), h1 = tr_read<v_rd_off<NCB>(D0, 1, 1)>(vb);
  const s16x4 l2 = tr_read<v_rd_off<NCB>(D0, 2, 0)>(vb), h2 = tr_read<v_rd_off<NCB>(D0, 2, 1)>(vb), l3 = tr_read<v_rd_off<NCB>(D0, 3, 0)>(vb), h3 = tr_read<v_rd_off<NCB>(D0, 3, 1)>(vb);
  asm volatile("s_waitcnt lgkmcnt(0)" ::: "memory"); ATT_SBAR();
#define PK(L, H) (bf16x8){L[0], L[1], L[2], L[3], H[0], H[1], H[2], H[3]}
  od = __builtin_amdgcn_mfma_f32_32x32x16_bf16(pa0, PK(l0, h0), od, 0, 0, 0);
  od = __builtin_amdgcn_mfma_f32_32x32x16_bf16(pa1, PK(l1, h1), od, 0, 0, 0);
  od = __builtin_amdgcn_mfma_f32_32x32x16_bf16(pa2, PK(l2, h2), od, 0, 0, 0);
  od = __builtin_amdgcn_mfma_f32_32x32x16_bf16(pa3, PK(l3, h3), od, 0, 0, 0);
#undef PK
}
struct Src { const bf16* kc; const bf16* vc; int cp; const bf16* kl; const bf16* vl; int lp; int nctx; int nt; int lat0; int q0; bool mask; };
constexpr int L_K = 0, L_V = 16384, L_WS = 32768, L_CMB = 65536;

template <int KW, int DV, bool ZS>
__device__ __forceinline__ void attn_unit(LAS unsigned char* lds, const bf16* Qrow0  , int qpitch, const Src& S,
                                          float sink_l2  , float lam, f32x16* o, int tid, int wave, int lane) {
  constexpr int NCB = DV / 32, NPK = KW / 64, NPV = DV / 64;
  const int r32 = lane & 31, hi = lane >> 5;
  const int qoff = ZS ? 32 * (wave >> 1) : 32 * wave; const int kcolB = ZS ? (wave & 1) * 128 : 0;
  LAS float* wsf = (LAS float*)(lds + L_WS) + wave * 64; LAS float* li_l = wsf; LAS float* al_l = wsf + 32;
  float m_reg = -1e30f, l_reg = 0.f;
#pragma unroll
  for (int d = 0; d < NCB; ++d) o[d] = f32x16{};
  bf16x8 qr[4];
  { const bf16* Qw = Qrow0 + (size_t)(qoff + r32) * qpitch + (ZS ? (wave & 1) * 64 : 0) + hi * 8;
#pragma unroll
    for (int d0 = 0; d0 < 4; ++d0) qr[d0] = *(const bf16x8*)(Qw + d0 * 16); }
  const int ksr = (KW == 64) ? (tid >> 3) : (tid >> 4), ksc = (KW == 64) ? (tid & 7) * 8 : (tid & 15) * 8;
  const int vsr = (DV == 64) ? (tid >> 3) : (tid >> 4), vsc = (DV == 64) ? (tid & 7) * 8 : (tid & 15) * 8;
  const int vb0 = (int)(size_t)(lds + L_V) + v_rd_base(lane);
  bf16x8 kst[NPK], vst[NPV];
#define ATT_LOAD(j) do { const bool cx = (j) < S.nctx; const bf16* kb = cx ? S.kc + (size_t)((j) * 64) * S.cp : S.kl + (size_t)(S.lat0 + ((j) - S.nctx) * 64) * S.lp; \
    const bf16* vbp = cx ? S.vc + (size_t)((j) * 64) * S.cp : S.vl + (size_t)(S.lat0 + ((j) - S.nctx) * 64) * S.lp; const int pt = cx ? S.cp : S.lp; \
    _Pragma("unroll") for (int i = 0; i < NPK; ++i) kst[i] = *(const bf16x8*)(kb + (size_t)(ksr + 32 * i) * pt + ksc); \
    _Pragma("unroll") for (int i = 0; i < NPV; ++i) vst[i] = *(const bf16x8*)(vbp + (size_t)(vsr + 32 * i) * pt + vsc); } while (0)
#define ATT_WRITE() do { \
    _Pragma("unroll") for (int i = 0; i < NPK; ++i) *(LAS bf16x8*)(lds + L_K + kswz<KW>(ksr + 32 * i, ksc * 2)) = kst[i]; \
    _Pragma("unroll") for (int i = 0; i < NPV; ++i) *(LAS bf16x8*)(lds + L_V + v_st<NCB>(vsr + 32 * i, vsc)) = vst[i]; } while (0)
  ATT_LOAD(0);
  for (int j = 0; j < S.nt; ++j) {
    __syncthreads();
    ATT_WRITE();
    __syncthreads();
    if (j + 1 < S.nt) ATT_LOAD(j + 1);
    f32x16 p0, p1; float alpha; bf16x8 pa0, pa1, pa2, pa3;
    ATT_SBAR(); qkt<KW>(p0, p1, lds + L_K, kcolB, qr, r32, hi);
    if (S.mask && j >= S.nctx) {
      const int qpos = S.q0 + qoff + r32, kb0 = S.lat0 + (j - S.nctx) * 64;
#pragma unroll
      for (int r = 0; r < 16; ++r) { const int k0 = kb0 + crow(r, hi) - qpos; if (k0 > 128 || k0 < -128) p0[r] = -1e30f; const int k1 = k0 + 32; if (k1 > 128 || k1 < -128) p1[r] = -1e30f; }
    }
    partialSM(p0, p1, m_reg, alpha);
    if (__any(alpha < 1.f)) { if (hi == 0) al_l[r32] = alpha; asm volatile("s_waitcnt lgkmcnt(0)" ::: "memory");
#pragma unroll
      for (int d = 0; d < NCB; ++d)
#pragma unroll
        for (int r = 0; r < 16; ++r) o[d][r] *= al_l[crow(r, hi)]; }
    finishSM(p0, p1, alpha, l_reg, pa0, pa1, pa2, pa3); ATT_SBAR();
    pv_one<NCB, 0>(o[0], vb0, pa0, pa1, pa2, pa3); pv_one<NCB, 1>(o[1], vb0, pa0, pa1, pa2, pa3);
    if constexpr (NCB == 4) { pv_one<NCB, 2>(o[2], vb0, pa0, pa1, pa2, pa3); pv_one<NCB, 3>(o[3], vb0, pa0, pa1, pa2, pa3); }
  }
#undef ATT_LOAD
#undef ATT_WRITE
  float lt = l_reg + __builtin_amdgcn_exp2f(sink_l2 - m_reg * CSC);
  if (hi == 0) li_l[r32] = lt; asm volatile("s_waitcnt lgkmcnt(0)" ::: "memory");
  float rli[16];
#pragma unroll
  for (int r = 0; r < 16; ++r) rli[r] = __builtin_amdgcn_rcpf(li_l[crow(r, hi)]);
#pragma unroll
  for (int d = 0; d < NCB; ++d)
#pragma unroll
    for (int r = 0; r < 16; ++r) o[d][r] *= rli[r];
  if constexpr (ZS) {
    LAS float* cb = (LAS float*)(lds + L_CMB) + (wave >> 1) * 4096;
    if (wave & 1) {
#pragma unroll
      for (int d = 0; d < NCB; ++d)
#pragma unroll
        for (int r = 0; r < 16; ++r) cb[(d * 16 + r) * 64 + lane] = o[d][r];
    }
    __syncthreads();
    if (!(wave & 1)) {
#pragma unroll
      for (int d = 0; d < NCB; ++d)
#pragma unroll
        for (int r = 0; r < 16; ++r) o[d][r] -= lam * cb[(d * 16 + r) * 64 + lane];
    }
  }
}
#undef ATT_SBAR
}
constexpr int RW_CH = 16;
constexpr int RW_GRP_BYTES = 9 * RW_CH * 64 * 4;
__device__ __forceinline__ float bf2f(bf16 v) { return __builtin_bit_cast(float, (unsigned)v << 16); }
template <bool SAMPLE>
__device__ __forceinline__ void rwkv_unit(const Params& P, LAS unsigned char* lds, int b, int h, int tid, int lane) {
    constexpr int T = SAMPLE ? 2048 : 256;
    const int rowbase = SAMPLE ? MP + b * 2048 : b * 256;
    const int g = tid >> 8, gt = tid & 255, wg = gt >> 6, row = wg * 16 + (lane >> 2), kq = lane & 3;
    const int c = gt & 63, tgp = gt >> 6, hc = h * 64 + c;
    LAS float* base = (LAS float*)(lds + g * RW_GRP_BYTES);
    LAS float* sW = base, *sKK = base + 1024, *sKKA = base + 2048, *sKE = base + 3072, *sR = base + 4096, *sV = base + 5120, *sXK = base + 6144, *sTW = base + 7168, *sAL = base + 8192;
    const bf16* PR = (const bf16*)(P.ws + WS_PROJ);
    const float* mu = P.in[I_MU];
    const float mu_r = mu[hc], mu_k = mu[512 + hc], mu_v = mu[1024 + hc], mu_w = mu[1536 + c], mu_a = mu[1600 + c];
    const float w0v = P.in[I_W0][g * 512 + hc], a0v = P.in[I_A0][g * 512 + hc], kkc = P.in[I_KK][hc], kac = P.in[I_KA][hc], rkc = P.in[I_RK][hc];
    const float* w2p = P.in[I_W2] + (size_t)g * 64 * 512 + hc; const float* a2p = P.in[I_A2] + (size_t)g * 64 * 512 + hc;
    float* Yd = (float*)(P.ws + (g ? WS_YB : WS_YF)); float* BON = (float*)(P.ws + WS_BONUS) + (size_t)g * M * 8;
    float S[16];
    if (SAMPLE) { const float* s0 = P.in[I_ST] + ((((size_t)b * 2 + g) * 8 + h) * 64 + row) * 64 + 16 * kq;
#pragma unroll
        for (int i = 0; i < 16; ++i) S[i] = s0[i]; }
    else {
#pragma unroll
        for (int i = 0; i < 16; ++i) S[i] = 0.f; }
    for (int ci = 0; ci < T / RW_CH; ++ci) {
        const int t0 = g ? (T - RW_CH - ci * RW_CH) : ci * RW_CH;
        {   float pv[6][5];
            const int ta = t0 + tgp * 4 - 1;
#pragma unroll
            for (int i = 0; i < 6; ++i) { const int t = ta + i; const bool ok = (t >= 0) && (t < T); const bf16* pr = PR + (size_t)(rowbase + (ok ? t : 0)) * N0 + 1280;
                pv[i][0] = ok ? bf2f(pr[hc]) : 0.f; pv[i][1] = ok ? bf2f(pr[512 + hc]) : 0.f; pv[i][2] = ok ? bf2f(pr[1024 + hc]) : 0.f;
                pv[i][3] = ok ? bf2f(pr[1536 + c]) : 0.f; pv[i][4] = ok ? bf2f(pr[1600 + c]) : 0.f; }
#pragma unroll
            for (int tt = 0; tt < 4; ++tt) { const int tl = tgp * 4 + tt;
                const float xr = pv[tt + 1][0] + (0.5f * (pv[tt][0] + pv[tt + 2][0]) - pv[tt + 1][0]) * mu_r;
                const float xk = pv[tt + 1][1] + (0.5f * (pv[tt][1] + pv[tt + 2][1]) - pv[tt + 1][1]) * mu_k;
                const float xv = pv[tt + 1][2] + (0.5f * (pv[tt][2] + pv[tt + 2][2]) - pv[tt + 1][2]) * mu_v;
                const float xw = pv[tt + 1][3] + (0.5f * (pv[tt][3] + pv[tt + 2][3]) - pv[tt + 1][3]) * mu_w;
                const float xa = pv[tt + 1][4] + (0.5f * (pv[tt][4] + pv[tt + 2][4]) - pv[tt + 1][4]) * mu_a;
                sR[tl * 64 + c] = xr; sXK[tl * 64 + c] = xk; sV[tl * 64 + c] = xv; sTW[tl * 64 + c] = tanhf(xw); sAL[tl * 64 + c] = xa; } }
        __syncthreads();
        {   float aw[4] = {0.f, 0.f, 0.f, 0.f}, aa[4] = {0.f, 0.f, 0.f, 0.f};
#pragma unroll 4
            for (int l = 0; l < 64; ++l) { const float w2v = w2p[(size_t)l * 512], a2v = a2p[(size_t)l * 512];
#pragma unroll
                for (int tt = 0; tt < 4; ++tt) { aw[tt] += sTW[(tgp * 4 + tt) * 64 + l] * w2v; aa[tt] += sAL[(tgp * 4 + tt) * 64 + l] * a2v; } }
#pragma unroll
            for (int tt = 0; tt < 4; ++tt) { const int tl = tgp * 4 + tt;
                const float wpre = -(w0v + aw[tt]);
                const float sp = fmaxf(wpre, 0.f) + log1pf(__expf(-fabsf(wpre)));
                const float w = -sp - 0.5f; const float dec = __expf(-__expf(w));
                const float a = 1.f / (1.f + __expf(-(a0v + aa[tt])));
                const float kraw = sXK[tl * 64 + c], kkr = kraw * kkc;
                const float nrm = sqrtf(wave_sum(kkr * kkr)); const float kk = kkr / fmaxf(nrm, 1e-12f);
                const float ke = kraw * (1.f + (a - 1.f) * kac);
                const float bs = wave_sum(sR[tl * 64 + c] * ke * rkc);
                sW[tl * 64 + c] = dec; sKK[tl * 64 + c] = kk; sKKA[tl * 64 + c] = kk * a; sKE[tl * 64 + c] = ke;
                if (c == 0) BON[(size_t)(rowbase + t0 + tl) * 8 + h] = bs; } }
        __syncthreads();
#pragma unroll 1
        for (int s = 0; s < RW_CH; ++s) { const int tl = g ? (RW_CH - 1 - s) : s;
            const LAS f32x4* pw = (const LAS f32x4*)(sW + tl * 64 + 16 * kq); const LAS f32x4* pk = (const LAS f32x4*)(sKK + tl * 64 + 16 * kq);
            const LAS f32x4* pb = (const LAS f32x4*)(sKKA + tl * 64 + 16 * kq); const LAS f32x4* pe = (const LAS f32x4*)(sKE + tl * 64 + 16 * kq);
            const LAS f32x4* pr = (const LAS f32x4*)(sR + tl * 64 + 16 * kq);
            const float vv = sV[tl * 64 + row];
            float sa = 0.f;
#pragma unroll
            for (int q = 0; q < 4; ++q) { const f32x4 k4 = pk[q]; sa -= S[4 * q] * k4[0] + S[4 * q + 1] * k4[1] + S[4 * q + 2] * k4[2] + S[4 * q + 3] * k4[3]; }
            sa += __shfl_xor(sa, 1); sa += __shfl_xor(sa, 2);
            float y = 0.f;
#pragma unroll
            for (int q = 0; q < 4; ++q) { const f32x4 w4 = pw[q], b4 = pb[q], e4 = pe[q], r4 = pr[q];
#pragma unroll
                for (int i = 0; i < 4; ++i) { const float sn = S[4 * q + i] * w4[i] + sa * b4[i] + vv * e4[i]; S[4 * q + i] = sn; y += sn * r4[i]; } }
            y += __shfl_xor(y, 1); y += __shfl_xor(y, 2);
            if (kq == 0) Yd[(size_t)(rowbase + t0 + tl) * 512 + h * 64 + row] = y;
        }
        __syncthreads();
    }
    if (!SAMPLE) { float* so = P.out + OUT_ST + ((((size_t)b * 2 + g) * 8 + h) * 64 + row) * 64 + 16 * kq;
#pragma unroll
        for (int q = 0; q < 4; ++q) *(f32x4*)(so + 4 * q) = (f32x4){S[4 * q], S[4 * q + 1], S[4 * q + 2], S[4 * q + 3]}; }
}
__device__ __forceinline__ void rwkv_post(const Params& P, int G, int vcu, int wave, int lane) {
    const int gw = vcu * NWAVES + wave, NGW = G * NWAVES;
    const bf16* PR = (const bf16*)(P.ws + WS_PROJ); bf16* MIX = (bf16*)(P.ws + WS_MIX);
    const float* YF = (const float*)(P.ws + WS_YF); const float* YB = (const float*)(P.ws + WS_YB); const float* BON = (const float*)(P.ws + WS_BONUS);
    for (int r = gw; r < M; r += NGW) {
        int t, T; if (r < MP) { t = r & 255; T = 256; } else { t = (r - MP) & 2047; T = 2048; }
        const bool hp = t > 0, hn = t + 1 < T;
        const bf16* p0 = PR + (size_t)r * N0; const bf16* pp = hp ? p0 - N0 : p0; const bf16* pn = hn ? p0 + N0 : p0;
#pragma unroll 2
        for (int h = 0; h < 8; ++h) { const int hc = h * 64 + lane;
            const float y = YF[(size_t)r * 512 + hc] + YB[(size_t)r * 512 + hc];
            const float mean = wave_sum(y) * (1.f / 64.f); const float d = y - mean; const float var = wave_sum(d * d) * (1.f / 64.f);
            const float yn = d * (1.f / sqrtf(var + 64e-5f)) * P.in[I_LNW][hc] + P.in[I_LNB][hc];
            const float pc = bf2f(p0[1280 + 1024 + hc]), pvp = hp ? bf2f(pp[1280 + 1024 + hc]) : 0.f, pvn = hn ? bf2f(pn[1280 + 1024 + hc]) : 0.f;
            const float xv = pc + (0.5f * (pvp + pvn) - pc) * P.in[I_MU][1024 + hc];
            const float bon = 0.5f * (BON[(size_t)r * 8 + h] + BON[(size_t)(M + r) * 8 + h]);
            const float gb = bf2f(p0[2944 + hc]);
            MIX[(size_t)r * D + 512 + hc] = (bf16)f2bf((yn + bon * xv) * silu_f(gb)); }
    }
}
__device__ __forceinline__ void p6_mid(const Params& P, LAS unsigned char* lds, int G, int vcu, int wave, int lane, int tid) {
    LAS float* gp = (LAS float*)lds; LAS float* gs = gp + 3 * 1024; LAS float* sh = gs + 3 * 1024;
    for (int i = tid; i < 3 * 1024; i += 512) { const int j = i >> 10, k = i & 1023;
        gp[i] = mod_val(P, 0, j, 2048 + k) * P.in[I_NPOST][k];
        gs[i] = P.in[I_NPRE][1024 + k] * (1.f + mod_val(P, 1, j, 1024 + k)); sh[i] = mod_val(P, 1, j, k); }
    __syncthreads();
    const int gw = vcu * NWAVES + wave, NGW = G * NWAVES;
    bf16* XN = (bf16*)(P.ws + WS_XN); const float* Y = (const float*)(P.ws + WS_Y);
    for (int r = gw; r < M; r += NGW) {
        const f32x4* xr = (const f32x4*)xrow(P, r) + lane; const f32x4* yr = (const f32x4*)(Y + (size_t)r * D) + lane; const int j = modidx(r);
        f32x4 y[4], x[4]; float s = 0.f;
#pragma unroll
        for (int q = 0; q < 4; ++q) { y[q] = yr[64 * q]; x[q] = xr[64 * q]; s += (y[q].x * y[q].x + y[q].y * y[q].y) + (y[q].z * y[q].z + y[q].w * y[q].w); }
        const float rinv = 1.f / sqrtf(wave_sum(s) * (1.f / D) + NORM_EPS);
        float s1 = 0.f; f32x4* orow = (f32x4*)(P.out + OUT_Y + (size_t)r * D) + lane;
#pragma unroll
        for (int q = 0; q < 4; ++q) { const LAS float* g = gp + j * 1024 + 256 * q + 4 * lane;
            x[q].x += g[0] * y[q].x * rinv; x[q].y += g[1] * y[q].y * rinv; x[q].z += g[2] * y[q].z * rinv; x[q].w += g[3] * y[q].w * rinv;
            orow[64 * q] = x[q]; s1 += (x[q].x * x[q].x + x[q].y * x[q].y) + (x[q].z * x[q].z + x[q].w * x[q].w); }
        const float rinv1 = 1.f / sqrtf(wave_sum(s1) * (1.f / D) + NORM_EPS);
        unsigned long long* o8 = (unsigned long long*)(XN + (size_t)r * D) + lane;
#pragma unroll
        for (int q = 0; q < 4; ++q) { const int k = 256 * q + 4 * lane; const LAS float* g = gs + j * 1024 + k; const LAS float* b = sh + j * 1024 + k;
            const float o0 = x[q].x * rinv1 * g[0] + b[0], o1 = x[q].y * rinv1 * g[1] + b[1], o2 = x[q].z * rinv1 * g[2] + b[2], o3 = x[q].w * rinv1 * g[3] + b[3];
            o8[64 * q] = (unsigned long long)pk2(o0, o1) | ((unsigned long long)pk2(o2, o3) << 32); }
    }
    __syncthreads();
}
__device__ __forceinline__ void p10_final(const Params& P, LAS unsigned char* lds, int G, int vcu, int wave, int lane, int tid) {
    LAS float* gp = (LAS float*)lds;
    for (int i = tid; i < 3 * 1024; i += 512) { const int j = i >> 10, k = i & 1023; gp[i] = mod_val(P, 1, j, 2048 + k) * P.in[I_NPOST][1024 + k]; }
    __syncthreads();
    const int gw = vcu * NWAVES + wave, NGW = G * NWAVES;
    const float* Y = (const float*)(P.ws + WS_Y);
    for (int r = gw; r < M; r += NGW) {
        f32x4* orow = (f32x4*)(P.out + OUT_Y + (size_t)r * D) + lane; const f32x4* yr = (const f32x4*)(Y + (size_t)r * D) + lane; const int j = modidx(r);
        f32x4 y[4], x[4]; float s = 0.f;
#pragma unroll
        for (int q = 0; q < 4; ++q) { y[q] = yr[64 * q]; x[q] = orow[64 * q]; s += (y[q].x * y[q].x + y[q].y * y[q].y) + (y[q].z * y[q].z + y[q].w * y[q].w); }
        const float rinv = 1.f / sqrtf(wave_sum(s) * (1.f / D) + NORM_EPS);
#pragma unroll
        for (int q = 0; q < 4; ++q) { const LAS float* g = gp + j * 1024 + 256 * q + 4 * lane;
            x[q].x += g[0] * y[q].x * rinv; x[q].y += g[1] * y[q].y * rinv; x[q].z += g[2] * y[q].z * rinv; x[q].w += g[3] * y[q].w * rinv;
            orow[64 * q] = x[q]; }
    }
    __syncthreads();
}
__device__ __forceinline__ void attnA_unit(const Params& P, LAS unsigned char* lds, bool sample, int b, int h, int qb, int tid, int wave, int lane) {
    const bf16* PR = (const bf16*)(P.ws + WS_PROJ); bf16* MIX = (bf16*)(P.ws + WS_MIX);
    const int g = h >> 2; att::Src S; int rowQ0;
    if (sample) { rowQ0 = MP + b * 2048 + qb * 256;
        S.kc = (const bf16*)(P.ws + WS_CAK) + (size_t)b * 256 * 128 + g * 64; S.vc = (const bf16*)(P.ws + WS_CAV) + (size_t)b * 256 * 128 + g * 64; S.cp = 128; S.nctx = 4;
        S.kl = PR + (size_t)(MP + b * 2048) * N0 + 512 + g * 64; S.vl = PR + (size_t)(MP + b * 2048) * N0 + 640 + g * 64; S.lp = N0;
        const int k0 = qb * 256 - 128 < 0 ? 0 : qb * 256 - 128, k1 = qb * 256 + 384 > 2048 ? 2048 : qb * 256 + 384;
        S.lat0 = k0; S.nt = 4 + (k1 - k0) / 64; S.q0 = qb * 256; S.mask = true;
    } else { rowQ0 = b * 256;
        S.kc = nullptr; S.vc = nullptr; S.cp = 0; S.nctx = 0; S.kl = PR + (size_t)(b * 256) * N0 + 512 + g * 64; S.vl = PR + (size_t)(b * 256) * N0 + 640 + g * 64; S.lp = N0;
        S.lat0 = 0; S.nt = 4; S.q0 = 0; S.mask = false; }
    att::f32x16 o[2];
    att::attn_unit<64, 64, false>(lds, PR + (size_t)rowQ0 * N0 + h * 64, N0, S, P.in[I_SINK][h] * 1.4426950408889634f, 0.f, o, tid, wave, lane);
    const int r32 = lane & 31, hi = lane >> 5;
#pragma unroll
    for (int r = 0; r < 16; ++r) { const int row = rowQ0 + 32 * wave + att::crow(r, hi);
#pragma unroll
        for (int d = 0; d < 2; ++d) { const int col = h * 64 + 32 * d + r32; const float ga = bf2f(PR[(size_t)row * N0 + 768 + col]);
            MIX[(size_t)row * D + col] = (bf16)f2bf(o[d][r] * silu_f(ga)); } }
}
__device__ __forceinline__ void attnC_unit(const Params& P, LAS unsigned char* lds, bool sample, int b, int h, int qb, float lam, int tid, int wave, int lane) {
    const bf16* PR = (const bf16*)(P.ws + WS_PROJ); bf16* MIX = (bf16*)(P.ws + WS_MIX);
    att::Src S; int rowQ0;
    if (sample) { rowQ0 = MP + b * 2048 + qb * 128;
        S.kc = (const bf16*)(P.ws + WS_CCK) + (size_t)b * 256 * 1024 + h * 128; S.vc = (const bf16*)(P.ws + WS_CCV) + (size_t)b * 256 * 1024 + h * 128; S.cp = 1024; S.nctx = 4;
        S.kl = PR + (size_t)(MP + b * 2048) * N1 + 1024 + h * 128; S.vl = PR + (size_t)(MP + b * 2048) * N1 + 2048 + h * 128; S.lp = N1; S.lat0 = 0; S.nt = 36; S.q0 = qb * 128; S.mask = false;
    } else { rowQ0 = b * 256 + qb * 128;
        S.kc = nullptr; S.vc = nullptr; S.cp = 0; S.nctx = 0; S.kl = PR + (size_t)(b * 256) * N1 + 1024 + h * 128; S.vl = PR + (size_t)(b * 256) * N1 + 2048 + h * 128; S.lp = N1;
        S.lat0 = 0; S.nt = 4; S.q0 = qb * 128; S.mask = false; }
    att::f32x16 o[4];
    att::attn_unit<128, 128, true>(lds, PR + (size_t)rowQ0 * N1 + h * 128, N1, S, -INFINITY, lam, o, tid, wave, lane);
    if (!(wave & 1)) {
        const int r32 = lane & 31, hi = lane >> 5; const float sc = 1.f - 0.35550906759f;
        float rs[16];
#pragma unroll
        for (int r = 0; r < 16; ++r) { float s = o[0][r] * o[0][r] + o[1][r] * o[1][r] + o[2][r] * o[2][r] + o[3][r] * o[3][r];
            s += __shfl_xor(s, 1); s += __shfl_xor(s, 2); s += __shfl_xor(s, 4); s += __shfl_xor(s, 8); s += __shfl_xor(s, 16);
            rs[r] = sc / sqrtf(s * (1.f / 128.f) + 1e-5f); }
#pragma unroll
        for (int r = 0; r < 16; ++r) { const int row = rowQ0 + 32 * (wave >> 1) + att::crow(r, hi);
#pragma unroll
            for (int d = 0; d < 4; ++d) { const int cc = 32 * d + r32; const float gc = bf2f(PR[(size_t)row * N1 + 3072 + h * 128 + cc]);
                MIX[(size_t)row * D + h * 128 + cc] = (bf16)f2bf(o[d][r] * rs[r] * P.in[I_SUBLN][cc] * silu_f(gc)); } }
    }
}
constexpr int NPH = 11;
__global__ void __launch_bounds__(NWAVES * 64, 2) mega_fwd(Params P) {
    extern __shared__ __attribute__((aligned(16))) unsigned char lds_raw[];
    LAS unsigned char* lds = (LAS unsigned char*)lds_raw;
    volatile LAS unsigned* MISC = (volatile LAS unsigned*)(lds + MISC_OFF);
    const int tid = threadIdx.x, lane = tid & 63, wave = __builtin_amdgcn_readfirstlane(tid >> 6);
    const int G = gridDim.x; const int bx = blockIdx.x; const int vcu = (G % 8 == 0) ? (bx % 8) * (G / 8) + bx / 8 : bx;
    gu32* ctl = (gu32*)(P.ws + WS_CTL);
    for (int u = tid; u < (LDS_BYTES - LDSCTL_OFF) / 4; u += NWAVES * 64) ((LAS unsigned*)(lds + LDSCTL_OFF))[u] = 0u;
    __syncthreads();
    XcdBarrier bar = xcd_barrier_post((unsigned*)(ctl + CW_BAR), MISC + 8);
    const int lo = P.ph_lo, hi = P.ph_hi;
#define IN(k) (lo <= (k) && (k) < hi)
#define SEAM(k) do { if (IN(k) && IN((k) + 1)) xcd_barrier(bar); } while (0)

    if (IN(0)) { p0_prologue(P, lds, G, vcu, wave, lane, tid); } SEAM(0);
    if (IN(1)) { p1_hprep(P, lds, G, vcu, wave, lane, tid); } SEAM(1);
    if (IN(2)) {
        pg8::Gemm g{(const pg8::bf16_t*)(P.ws + WS_XN), (const pg8::bf16_t*)(P.ws + WS_WT0), M, N0P, D}; pg8::StaticOrder S; S.init(M, N0P, G, bx);
        pg8::EpiIn E{(pg8::bf16_t*)(P.ws + WS_PROJ), N0, N0, 640, (const float*)(P.ws + WS_ROPE), P.out + OUT_AK, P.out + OUT_AV, 512, 640, 640, 768, 128, 128};
        pg8::gemm_phase<pg8::EpiIn, pg8::StaticOrder, true, true>(lds, g, S, E);
    } SEAM(2);
    if (IN(3)) {
        for (int u = bx; u < 656; u += G) {
            if (u < 16) rwkv_unit<true>(P, lds, u >> 3, u & 7, tid, lane);
            else if (u < 272) rwkv_unit<false>(P, lds, (u - 16) >> 3, (u - 16) & 7, tid, lane);
            else if (u < 400) { const int i = u - 272; attnA_unit(P, lds, true, i >> 6, (i >> 3) & 7, i & 7, tid, wave, lane); }
            else { const int i = u - 400; attnA_unit(P, lds, false, i >> 3, i & 7, 0, tid, wave, lane); }
            __syncthreads();
        }
    } SEAM(3);
    if (IN(4)) { rwkv_post(P, G, vcu, wave, lane); } SEAM(4);
    if (IN(5)) {
        pg8::Gemm g{(const pg8::bf16_t*)(P.ws + WS_MIX), (const pg8::bf16_t*)(P.ws + WS_WO0), M, D, D}; pg8::StaticOrder S; S.init(M, D, G, bx);
        pg8::EpiF32 E{(float*)(P.ws + WS_Y), D};
        pg8::gemm_phase<pg8::EpiF32, pg8::StaticOrder, true, true>(lds, g, S, E);
    } SEAM(5);
    if (IN(6)) { p6_mid(P, lds, G, vcu, wave, lane, tid); } SEAM(6);
    if (IN(7)) {
        pg8::Gemm g{(const pg8::bf16_t*)(P.ws + WS_XN), (const pg8::bf16_t*)(P.ws + WS_WT1), M, N1, D}; pg8::StaticOrder S; S.init(M, N1, G, bx);
        pg8::EpiIn E{(pg8::bf16_t*)(P.ws + WS_PROJ), N1, N1, 2048, (const float*)(P.ws + WS_ROPE), P.out + OUT_CK, P.out + OUT_CV, 1024, 2048, 2048, 3072, 1024, 1024};
        pg8::gemm_phase<pg8::EpiIn, pg8::StaticOrder, true, true>(lds, g, S, E);
    } SEAM(7);
    if (IN(8)) {
        const float d1 = wave_sum(P.in[I_LQ1][lane] * P.in[I_LK1][lane]), d2 = wave_sum(P.in[I_LQ2][lane] * P.in[I_LK2][lane]);
        const float lam = expf(d1) - expf(d2) + 0.35550906759f;
        for (int u = bx; u < 768; u += G) {
            if (u < 256) attnC_unit(P, lds, true, u >> 7, (u >> 4) & 7, u & 15, lam, tid, wave, lane);
            else { const int i = u - 256; attnC_unit(P, lds, false, i >> 4, (i >> 1) & 7, i & 1, lam, tid, wave, lane); }
            __syncthreads();
        }
    } SEAM(8);
    if (IN(9)) {
        pg8::Gemm g{(const pg8::bf16_t*)(P.ws + WS_MIX), (const pg8::bf16_t*)(P.ws + WS_WO1), M, D, D}; pg8::StaticOrder S; S.init(M, D, G, bx);
        pg8::EpiF32 E{(float*)(P.ws + WS_Y), D};
        pg8::gemm_phase<pg8::EpiF32, pg8::StaticOrder, true, true>(lds, g, S, E);
    } SEAM(9);
    if (IN(10)) { p10_final(P, lds, G, vcu, wave, lane, tid); }
#undef IN
#undef SEAM
}

extern "C" void kernel_launch(void* const* d_in, const int* in_sizes, int n_in, void* d_out, int out_size, void* d_ws, size_t ws_size, hipStream_t stream) {
    static int grid = 0;
    if (grid == 0) {
        if (n_in != 32 || out_size != 33554432 || ws_size < WS_END) { fprintf(stderr, "kernel_launch: unexpected shapes (n_in %d out %d ws %zu)\n", n_in, out_size, ws_size); grid = -1; return; }
        int dev = 0, cus = 0, per_cu = 0;
        if (hipGetDevice(&dev) != hipSuccess || hipDeviceGetAttribute(&cus, hipDeviceAttributeMultiprocessorCount, dev) != hipSuccess) { grid = -1; return; }
        if (hipFuncSetAttribute((const void*)mega_fwd, hipFuncAttributeMaxDynamicSharedMemorySize, LDS_BYTES) != hipSuccess) { fprintf(stderr, "kernel_launch: hipFuncSetAttribute failed\n"); grid = -1; return; }
        if (hipOccupancyMaxActiveBlocksPerMultiprocessor(&per_cu, (const void*)mega_fwd, NWAVES * 64, LDS_BYTES) != hipSuccess || per_cu < 1) { fprintf(stderr, "kernel_launch: occupancy query says %d\n", per_cu); per_cu = 1; }
        (void)hipGetLastError();
        grid = cus;
    }
    if (grid < 0) return;
    (void)hipMemsetAsync((char*)d_ws + WS_CTL, 0, CTL_ZERO_BYTES, stream);
    Params a{};
    for (int i = 0; i < 32; ++i) a.in[i] = (const float*)d_in[i];
    a.out = (float*)d_out; a.ws = (unsigned char*)d_ws;
#ifndef MK_PER_PHASE
    a.ph_lo = 0; a.ph_hi = NPH;
    hipLaunchKernelGGL(mega_fwd, dim3(grid), dim3(NWAVES * 64), LDS_BYTES, stream, a);
#else
    for (int p = 0; p < NPH; ++p) { a.ph_lo = p; a.ph_hi = p + 1; hipLaunchKernelGGL(mega_fwd, dim3(grid), dim3(NWAVES * 64), LDS_BYTES, stream, a); }
#endif
    const hipError_t le = hipPeekAtLastError();
    if (le != hipSuccess) fprintf(stderr, "kernel_launch: launch failed: %s\n", hipGetErrorName(le));
}
```

```cpp
#include <hip/hip_runtime.h>
#include <cstdio>
#include <cstdint>
namespace pg8 {
#define PG8_LAS __attribute__((address_space(3)))
typedef unsigned short bf16_t;
typedef short bf16x8 __attribute__((ext_vector_type(8)));
typedef float f32x4 __attribute__((ext_vector_type(4)));
typedef unsigned u32x4 __attribute__((ext_vector_type(4)));
constexpr int BM = 256, BK = 64, HALF = 128, HTB = HALF * BK * 2  , STAGE_BYTES = 8 * HTB, NXCD = 8, WGM = 8;

__host__ __device__ __forceinline__ int lds_byte(int r, int c) { const int st = (r >> 4) * 2 + (c >> 5), rr = r & 15, cc = c & 31, ob = rr * 64 + cc * 2; return st * 1024 + (ob ^ (((ob >> 9) & 1) << 5)); }
__host__ __device__ __forceinline__ void stage_rc(int b, int& R, int& C) { const int st = b / 1024, sb = b % 1024, swz = sb ^ (((sb >> 9) & 1) << 5); R = (st >> 1) * 16 + swz / 64; C = (st & 1) * 32 + (swz % 64) / 2; }
__host__ __device__ __forceinline__ int perm32(int rho) { const int n = rho >> 4, i = rho & 15; return 8 * (i >> 2) + 4 * n + (i & 3); }

struct Unit { int pm, pn; };
struct Gemm { const bf16_t* A; const bf16_t* Bt; int M, N, K; };

struct StaticOrder {
    int nM, nN, nwg, G, c;
    __host__ __device__ void init(int M, int N, int G_, int c_) { nM = M / BM; nN = N / BM; nwg = nM * nN; G = G_; c = c_; }
    __host__ __device__ bool next(int i, Unit& u) const {
        const long L = (long)i * G + c; if (L >= nwg) return false;
        int wgid = (int)L; { const int q = nwg / NXCD, r = nwg % NXCD, xcd = wgid % NXCD, off = wgid / NXCD; wgid = (xcd < r ? xcd * (q + 1) : r * (q + 1) + (xcd - r) * q) + off; }
        const int nig = WGM * nN, gid = wgid / nig, fm = gid * WGM, gsz = (nM - fm) < WGM ? (nM - fm) : WGM;
        u.pm = fm + ((wgid % nig) % gsz); u.pn = (wgid % nig) / gsz; return true;
    }
    __device__ __forceinline__ void a_ready(const Unit&) const {}
    __device__ __forceinline__ void done(const Unit&) const {}
};

__device__ __forceinline__ unsigned cvt_pk_bf16(float lo, float hi) { unsigned r; asm volatile("v_cvt_pk_bf16_f32 %0, %1, %2" : "=v"(r) : "v"(lo), "v"(hi)); return r; }
typedef float f32x2 __attribute__((ext_vector_type(2)));
struct EpiF32 {
    static constexpr bool PERM = false, AFTER_DRAIN = false;
    float* C; int ldc;
    __device__ __forceinline__ void operator()(const f32x4 (&acc)[2][2][4][2], const Unit& u, int wr, int wc, int fr, int fq) const {
        const int row0 = u.pm * BM + wr * 64 + fr, col0 = u.pn * BM + wc * 32 + 4 * fq;
#pragma unroll
        for (int ai = 0; ai < 2; ++ai)
#pragma unroll
            for (int m = 0; m < 4; ++m) { float* rowp = C + (size_t)(row0 + ai * HALF + m * 16) * ldc + col0;
#pragma unroll
                for (int bj = 0; bj < 2; ++bj)
#pragma unroll
                    for (int n = 0; n < 2; ++n) *(f32x4*)(rowp + bj * HALF + n * 16) = acc[ai][bj][m][n]; }
    }
};
struct EpiIn {
    static constexpr bool PERM = true, AFTER_DRAIN = false;
    bf16_t* O; int ldc; int nvalid; int rope_cols; const float* rope;
    float* out_k; float* out_v; int ck0, ck1, cv0, cv1, cpk, cpv;
    __device__ __forceinline__ void operator()(const f32x4 (&acc)[2][2][4][2], const Unit& u, int wr, int wc, int fr, int fq) const {
#pragma unroll
        for (int bj = 0; bj < 2; ++bj) {
            const int colbase = u.pn * BM + bj * HALF;
            if (colbase >= nvalid) continue;
            const int col0 = colbase + wc * 32 + 8 * fq;
            const bool dorope = (u.pm >= 32) && (colbase < rope_cols);
            const bool isk = (u.pm < 32) && (colbase >= ck0) && (colbase < ck1);
            const bool isv = (u.pm < 32) && (colbase >= cv0) && (colbase < cv1);
#pragma unroll
            for (int ai = 0; ai < 2; ++ai)
#pragma unroll
                for (int m = 0; m < 4; ++m) {
                    const int row = u.pm * BM + ai * HALF + wr * 64 + m * 16 + fr;
                    f32x4 v0 = acc[ai][bj][m][0], v1 = acc[ai][bj][m][1];
                    if (dorope) {
                        const int t = (row - 8192) & 2047; const int pos = (wc & 1) ? (t & 63) : (t >> 6);
                        const float* cs = rope + (pos * 16 + 8 * (fq & 1)) * 2;
                        const float sg = (fq < 2) ? -1.f : 1.f;
                        f32x4 p0, p1;
#pragma unroll
                        for (int i = 0; i < 4; ++i) { p0[i] = __shfl_xor(v0[i], 32); p1[i] = __shfl_xor(v1[i], 32); }
                        const f32x4 c0 = *(const f32x4*)(cs), c1 = *(const f32x4*)(cs + 4), c2 = *(const f32x4*)(cs + 8), c3 = *(const f32x4*)(cs + 12);
                        v0[0] = v0[0] * c0[0] + sg * p0[0] * c0[1]; v0[1] = v0[1] * c0[2] + sg * p0[1] * c0[3];
                        v0[2] = v0[2] * c1[0] + sg * p0[2] * c1[1]; v0[3] = v0[3] * c1[2] + sg * p0[3] * c1[3];
                        v1[0] = v1[0] * c2[0] + sg * p1[0] * c2[1]; v1[1] = v1[1] * c2[2] + sg * p1[1] * c2[3];
                        v1[2] = v1[2] * c3[0] + sg * p1[2] * c3[1]; v1[3] = v1[3] * c3[2] + sg * p1[3] * c3[3];
                    }
                    u32x4 w; w.x = cvt_pk_bf16(v0[0], v0[1]); w.y = cvt_pk_bf16(v0[2], v0[3]); w.z = cvt_pk_bf16(v1[0], v1[1]); w.w = cvt_pk_bf16(v1[2], v1[3]);
                    *(u32x4*)(O + (size_t)row * ldc + col0) = w;
                    if (isk) { float* p = out_k + (size_t)row * cpk + (col0 - ck0); *(f32x4*)p = v0; *(f32x4*)(p + 4) = v1; }
                    if (isv) { float* p = out_v + (size_t)row * cpv + (col0 - cv0); *(f32x4*)p = v0; *(f32x4*)(p + 4) = v1; }
                }
        }
    }
};
template <class Epi, class Sched, bool ALIGN_EPI = false, bool SP2 = false>
__device__ __forceinline__ void gemm_phase(PG8_LAS unsigned char* lds, const Gemm g, const Sched& S, const Epi& E) {
    const int tid = threadIdx.x, wid = __builtin_amdgcn_readfirstlane(tid >> 6), lane = tid & 63, wr = wid >> 2, wc = wid & 3, fr = lane & 15, fq = lane >> 4;
    const int K = g.K, nt = K / BK;
    unsigned voffA[2], voffB[2];
#pragma unroll
    for (int i = 0; i < 2; ++i) { int R, C; stage_rc(tid * 16 + i * 8192, R, C); const int Rb = Epi::PERM ? ((R & ~31) + perm32(R & 31)) : R;
        voffA[i] = (unsigned)(R * K + C) * 2u; voffB[i] = (unsigned)(Rb * K + C) * 2u; }
    const size_t kstep = (size_t)(BK * 2);
    const size_t hstep = (size_t)HALF * K * 2;
    const size_t tstep = 2 * hstep;
    const unsigned ldsw = (unsigned)wid * 1024u;
    const int aoff = lds_byte(wr * 64 + fr, fq * 8), boff = lds_byte(wc * 32 + fr, fq * 8);
#define PG8_SA(b, h) (((b) * 2 + (h)) * HTB)
#define PG8_SB(b, h) ((4 + (b) * 2 + (h)) * HTB)
#define PG8_STAGE(bufoff, gbase, voff) do { _Pragma("unroll") for (int _i = 0; _i < 2; ++_i) \
        __builtin_amdgcn_global_load_lds((const unsigned*)((const char*)(gbase) + (voff)[_i]), (PG8_LAS unsigned*)(lds + (bufoff) + ldsw + _i * 8192), 16, 0, 0); } while (0)
#define PG8_LDA(dst, b, h) do { _Pragma("unroll") for (int m = 0; m < 4; ++m) _Pragma("unroll") for (int k = 0; k < 2; ++k) dst[m][k] = *(const PG8_LAS bf16x8*)(lds + PG8_SA(b, h) + aoff + m * 2048 + k * 1024); } while (0)
#define PG8_LDB(dst, b, h) do { _Pragma("unroll") for (int n = 0; n < 2; ++n) _Pragma("unroll") for (int k = 0; k < 2; ++k) dst[n][k] = *(const PG8_LAS bf16x8*)(lds + PG8_SB(b, h) + boff + n * 2048 + k * 1024); } while (0)
#define PG8_MMA(ai, bj, At, Bt) do { __builtin_amdgcn_s_setprio(1); _Pragma("unroll") for (int m = 0; m < 4; ++m) _Pragma("unroll") for (int n = 0; n < 2; ++n) _Pragma("unroll") for (int k = 0; k < 2; ++k) \
        acc[ai][bj][m][n] = __builtin_amdgcn_mfma_f32_16x16x32_bf16(Bt[n][k], At[m][k], acc[ai][bj][m][n], 0, 0, 0); __builtin_amdgcn_s_setprio(0); } while (0)
#define PG8_WAIT_V(n) asm volatile("s_waitcnt vmcnt(" #n ")" ::: "memory")
#define PG8_WAIT_L(n) asm volatile("s_waitcnt lgkmcnt(" #n ")" ::: "memory")
#define PG8_BAR __builtin_amdgcn_s_barrier()
#define PG8_SCHED __builtin_amdgcn_sched_barrier(0)
    Unit cur, nxt; int ui = 0;
    if (!S.next(0, cur)) return;
    f32x4 acc[2][2][4][2];
#pragma unroll
    for (int a = 0; a < 2; ++a)
#pragma unroll
        for (int b = 0; b < 2; ++b)
#pragma unroll
            for (int m = 0; m < 4; ++m)
#pragma unroll
                for (int n = 0; n < 2; ++n) acc[a][b][m][n] = (f32x4){0.f, 0.f, 0.f, 0.f};
    bf16x8 At[4][2], B0[2][2], B1[2][2];
    const char* cA = (const char*)g.A + (size_t)cur.pm * tstep; const char* cB = (const char*)g.Bt + (size_t)cur.pn * tstep;
    S.a_ready(cur);
    if constexpr (SP2) {
        PG8_STAGE(PG8_SB(0, 0), cB, voffB); PG8_STAGE(PG8_SB(0, 1), cB + hstep, voffB); PG8_STAGE(PG8_SA(0, 0), cA, voffA); PG8_STAGE(PG8_SA(0, 1), cA + hstep, voffA);
        if (wr == 1) PG8_BAR;
        PG8_WAIT_V(2); PG8_BAR;
        PG8_STAGE(PG8_SB(1, 0), cB + kstep, voffB); PG8_STAGE(PG8_SA(1, 0), cA + kstep, voffA); PG8_STAGE(PG8_SB(1, 1), cB + hstep + kstep, voffB);
        PG8_WAIT_V(6); PG8_BAR;
    } else {
        PG8_STAGE(PG8_SB(0, 0), cB, voffB); PG8_STAGE(PG8_SA(0, 0), cA, voffA); PG8_STAGE(PG8_SB(0, 1), cB + hstep, voffB); PG8_STAGE(PG8_SA(0, 1), cA + hstep, voffA);
        if (wr == 1) PG8_BAR;
        PG8_WAIT_V(4); PG8_BAR;
        PG8_STAGE(PG8_SB(1, 0), cB + kstep, voffB); PG8_STAGE(PG8_SA(1, 0), cA + kstep, voffA); PG8_STAGE(PG8_SB(1, 1), cB + hstep + kstep, voffB);
        PG8_WAIT_V(6); PG8_BAR;
    }
    for (;;) {
        const bool has_next = S.next(ui + 1, nxt);
        const char* nA = has_next ? (const char*)g.A + (size_t)nxt.pm * tstep : cA; const char* nB = has_next ? (const char*)g.Bt + (size_t)nxt.pn * tstep : cB;
        for (int t = 0; t < nt; t += 2) {
            const bool last = (t == nt - 2);
            const char* a1 = cA + (size_t)(t + 1) * kstep;
            const char* a2 = last ? nA : cA + (size_t)(t + 2) * kstep; const char* b2 = last ? nB : cB + (size_t)(t + 2) * kstep;
            const char* a3 = a2 + kstep; const char* b3 = b2 + kstep;
            if (last && has_next) S.a_ready(nxt);
            if constexpr (SP2) {
            PG8_LDB(B0, 0, 0); PG8_LDB(B1, 0, 1); PG8_SCHED; PG8_LDA(At, 0, 0); PG8_STAGE(PG8_SA(1, 1), a1 + hstep, voffA);
            PG8_WAIT_V(8); PG8_WAIT_L(0); PG8_BAR; PG8_MMA(0, 0, At, B0); PG8_MMA(0, 1, At, B1); PG8_BAR; PG8_SCHED;
            PG8_LDA(At, 0, 1); PG8_STAGE(PG8_SB(0, 0), b2, voffB); PG8_STAGE(PG8_SB(0, 1), b2 + hstep, voffB); PG8_STAGE(PG8_SA(0, 0), a2, voffA);
            PG8_WAIT_V(8); PG8_WAIT_L(0); PG8_BAR; PG8_MMA(1, 0, At, B0); PG8_MMA(1, 1, At, B1); PG8_BAR; PG8_SCHED;
            PG8_LDB(B0, 1, 0); PG8_LDB(B1, 1, 1); PG8_SCHED; PG8_LDA(At, 1, 0); PG8_STAGE(PG8_SA(0, 1), a2 + hstep, voffA);
            PG8_WAIT_V(8); PG8_WAIT_L(0); PG8_BAR; PG8_MMA(0, 0, At, B0); PG8_MMA(0, 1, At, B1); PG8_BAR; PG8_SCHED;
            PG8_LDA(At, 1, 1); PG8_STAGE(PG8_SB(1, 0), b3, voffB); PG8_STAGE(PG8_SB(1, 1), b3 + hstep, voffB); PG8_STAGE(PG8_SA(1, 0), a3, voffA);
            PG8_WAIT_V(8); PG8_WAIT_L(0); PG8_BAR; PG8_MMA(1, 0, At, B0); PG8_MMA(1, 1, At, B1); PG8_BAR; PG8_SCHED;
            } else {
            PG8_LDB(B0, 0, 0); PG8_SCHED; PG8_LDA(At, 0, 0); PG8_STAGE(PG8_SA(1, 1), a1 + hstep, voffA);
            PG8_WAIT_L(8); PG8_BAR; PG8_WAIT_L(0); PG8_MMA(0, 0, At, B0); PG8_BAR; PG8_SCHED;
            PG8_LDB(B1, 0, 1); PG8_STAGE(PG8_SB(0, 0), b2, voffB);
            PG8_BAR; PG8_WAIT_L(0); PG8_MMA(0, 1, At, B1); PG8_BAR;
            PG8_LDA(At, 0, 1); PG8_STAGE(PG8_SA(0, 0), a2, voffA);
            PG8_BAR; PG8_WAIT_L(0); PG8_MMA(1, 0, At, B0); PG8_BAR; PG8_SCHED;
            PG8_STAGE(PG8_SB(0, 1), b2 + hstep, voffB);
            PG8_WAIT_V(6); PG8_BAR; PG8_MMA(1, 1, At, B1); PG8_BAR;
            PG8_LDB(B0, 1, 0); PG8_SCHED; PG8_LDA(At, 1, 0); PG8_STAGE(PG8_SA(0, 1), a2 + hstep, voffA);
            PG8_WAIT_L(8); PG8_BAR; PG8_WAIT_L(0); PG8_MMA(0, 0, At, B0); PG8_BAR; PG8_SCHED;
            PG8_LDB(B1, 1, 1); PG8_STAGE(PG8_SB(1, 0), b3, voffB);
            PG8_BAR; PG8_WAIT_L(0); PG8_MMA(0, 1, At, B1); PG8_BAR;
            PG8_LDA(At, 1, 1); PG8_STAGE(PG8_SA(1, 0), a3, voffA);
            PG8_BAR; PG8_WAIT_L(0); PG8_MMA(1, 0, At, B0); PG8_BAR; PG8_SCHED;
            PG8_STAGE(PG8_SB(1, 1), b3 + hstep, voffB);
            PG8_WAIT_V(6); PG8_BAR; PG8_MMA(1, 1, At, B1); PG8_BAR;
            }
        }
        if constexpr (ALIGN_EPI) { if (wr == 0) PG8_BAR; }
        if constexpr (!Epi::AFTER_DRAIN) { E(acc, cur, wr, wc, fr, fq); S.done(cur); }
        if (!has_next) break;
#pragma unroll
        for (int a = 0; a < 2; ++a)
#pragma unroll
            for (int b = 0; b < 2; ++b)
#pragma unroll
                for (int m = 0; m < 4; ++m)
#pragma unroll
                    for (int n = 0; n < 2; ++n) acc[a][b][m][n] = (f32x4){0.f, 0.f, 0.f, 0.f};
        cur = nxt; cA = nA; cB = nB; ++ui;
        if constexpr (ALIGN_EPI) { if (wr == 1) PG8_BAR; }
    }
    PG8_WAIT_V(0);
    if constexpr (!ALIGN_EPI) { if (wr == 0) PG8_BAR; }
    PG8_BAR;
    if constexpr (Epi::AFTER_DRAIN) { E.fused(acc, cur, wr, wc, fr, fq, lds, wid, lane); S.done(cur); }
#undef PG8_SA
#undef PG8_SB
#undef PG8_STAGE
#undef PG8_LDA
#undef PG8_LDB
#undef PG8_MMA
#undef PG8_WAIT_V
#undef PG8_WAIT_L
#undef PG8_BAR
#undef PG8_SCHED
}
}
#define GAS __attribute__((address_space(1)))
#define LAS __attribute__((address_space(3)))
typedef unsigned short bf16;
typedef unsigned v4u __attribute__((ext_vector_type(4)));
typedef float f32x4 __attribute__((ext_vector_type(4)));
typedef short bf16x8 __attribute__((ext_vector_type(8)));
typedef GAS unsigned gu32;
typedef GAS unsigned long long gu64;
#define RLX_AGENT __ATOMIC_RELAXED, __HIP_MEMORY_SCOPE_AGENT
#define LDS_WAIT() asm volatile("s_waitcnt lgkmcnt(0)" ::: "memory")
#define VM_WAIT() asm volatile("s_waitcnt vmcnt(0)" ::: "memory")
__device__ __forceinline__ unsigned long long rt() { return __builtin_amdgcn_s_memrealtime(); }
__device__ __forceinline__ unsigned f2bf(float f) { unsigned u = __builtin_bit_cast(unsigned, f); return (u + 0x7fffu + ((u >> 16) & 1u)) >> 16; }
__device__ __forceinline__ unsigned pk2(float lo, float hi) { return f2bf(lo) | (f2bf(hi) << 16); }

#define XB_TMO      128
#define XB_XCNT(j)  (256  + 64 * (j))
#define XB_XSUB(j)  (1280 + 64 * (j))
#define XB_XGEN(j)  (2304 + 64 * (j))
#define XB_TOP      3328
#define XB_TOPGEN   3392
#define XCD_BAR_WORDS 3456
#define XB_SPIN_CAP (1u << 18)

__device__ __forceinline__ unsigned xb_ld(unsigned* p)              { return __hip_atomic_load(p, __ATOMIC_RELAXED, __HIP_MEMORY_SCOPE_AGENT); }
__device__ __forceinline__ unsigned xb_add(unsigned* p, unsigned v) { return __hip_atomic_fetch_add(p, v, __ATOMIC_RELAXED, __HIP_MEMORY_SCOPE_AGENT); }
__device__ __forceinline__ unsigned xb_xcc_id() { return (unsigned)__builtin_amdgcn_s_getreg((3 << 11) | 20) & 0xFu; }
#define XB_SPIN(cond, bar) do { unsigned _sp = 0; while (cond) { __builtin_amdgcn_s_sleep(1); \
    if ((++_sp & 255u) == 0u) { if (xb_ld(&(bar)[XB_TMO])) break; if (_sp > XB_SPIN_CAP) { atomicAdd(&(bar)[XB_TMO], 1u); break; } } } } while (0)

struct XcdBarrier {
    unsigned* bar; unsigned x;
    volatile LAS unsigned* st;
};

__device__ __forceinline__ XcdBarrier xcd_barrier_post(unsigned* bar, volatile LAS unsigned* st) {
    XcdBarrier b; b.bar = bar; b.x = xb_xcc_id(); b.st = st;
    if (threadIdx.x == 0) (void)xb_add(&bar[XB_XCNT(b.x)], 1u);
    return b;
}
__device__ __forceinline__ void xcd_barrier_complete(unsigned* bar, unsigned x, unsigned& nloc, unsigned& nx) {
    const unsigned G = gridDim.x * gridDim.y * gridDim.z;
    unsigned sum, cnt, mine, sp = 0u;
    for (;;) {
        sum = 0u; cnt = 0u; mine = 0u;
#pragma unroll
        for (unsigned j = 0; j < 16; ++j) { const unsigned c = xb_ld(&bar[XB_XCNT(j)]); sum += c; cnt += (c > 0u) ? 1u : 0u; mine = (j == x) ? c : mine; }
        if (sum == G) break;
        __builtin_amdgcn_s_sleep(1);
        if ((++sp & 255u) == 0u) { if (xb_ld(&bar[XB_TMO])) break; if (sp > XB_SPIN_CAP) { atomicAdd(&bar[XB_TMO], 1u); break; } }
    }
    nloc = mine > 0u ? mine : 1u; nx = cnt > 0u ? cnt : 1u;
}

__device__ __forceinline__ void xcd_barrier(const XcdBarrier& b) {
    asm volatile("s_waitcnt vmcnt(0)" ::: "memory");
    __syncthreads();
    if (threadIdx.x == 0) {
        unsigned* bar = b.bar;
        __builtin_amdgcn_s_waitcnt(0);
        unsigned nloc = b.st[0], nx = b.st[1];
        if (nloc == 0u) { xcd_barrier_complete(bar, b.x, nloc, nx); b.st[0] = nloc; b.st[1] = nx; }
        const unsigned old = xb_add(&bar[XB_XSUB(b.x)], 1u);
        const unsigned gen = old / nloc;
        if (old + 1u == (gen + 1u) * nloc) {
            __builtin_amdgcn_fence(__ATOMIC_RELEASE, "agent");
            asm volatile("s_waitcnt vmcnt(0)" ::: "memory");
            const unsigned og = xb_add(&bar[XB_TOP], 1u);
            const unsigned tg = og / nx;
            if (og + 1u == (tg + 1u) * nx) xb_add(&bar[XB_TOPGEN], 1u);
            else XB_SPIN(xb_ld(&bar[XB_TOPGEN]) == tg, bar);
            __builtin_amdgcn_fence(__ATOMIC_ACQUIRE, "agent");
            xb_add(&bar[XB_XGEN(b.x)], 1u);
            asm volatile("s_waitcnt vmcnt(0)" ::: "memory");
        } else {
            XB_SPIN(xb_ld(&bar[XB_XGEN(b.x)]) == gen, bar);
            __builtin_amdgcn_fence(__ATOMIC_ACQUIRE, "agent");
            asm volatile("s_waitcnt vmcnt(0)" ::: "memory");
        }
    }
    __syncthreads();
}
constexpr int NWAVES = 8;
constexpr int D = 1024, MP = 8192, MS = 4096, M = MP + MS;
constexpr int N0 = 3456, N0P = 3584, N1 = 4096;
constexpr float NORM_EPS = 1e-6f;
constexpr size_t OUT_Y = 0, OUT_AK = 12582912, OUT_AV = 13631488, OUT_ST = 14680064, OUT_CK = 16777216, OUT_CV = 25165824;
constexpr size_t MiB = 1u << 20;
constexpr size_t WS_CTL = 0, CTL_ZERO_BYTES = 64 * 1024;
constexpr size_t WS_WT0 = 2 * MiB, WS_WO0 = 9 * MiB, WS_WT1 = 11 * MiB, WS_WO1 = 19 * MiB;
constexpr size_t WS_MODP = 21 * MiB, WS_ROPE = 22 * MiB, WS_LORA = 22 * MiB + 65536;
constexpr size_t WS_CAK = 23 * MiB, WS_CAV = WS_CAK + 131072, WS_CCK = WS_CAV + 131072, WS_CCV = WS_CCK + MiB;
constexpr size_t WS_BONUS = 26 * MiB, WS_XN = 27 * MiB, WS_MIX = 51 * MiB, WS_PROJ = 75 * MiB, WS_Y = 171 * MiB, WS_REC = 171 * MiB, WS_YF = 27 * MiB, WS_YB = 225 * MiB, WS_END = 249 * MiB;
constexpr int CW_BAR = 4096;
constexpr int RING_BYTES = 131072, LDSCTL_OFF = RING_BYTES, MISC_OFF = LDSCTL_OFF + 320, LDS_BYTES = 147456;

struct Params { const float* in[32]; float* out; unsigned char* ws; int ph_lo, ph_hi; };
enum { I_XP = 0, I_XS, I_CAK, I_CAV, I_ST, I_CCK, I_CCV, I_C, I_CCTX, I_ADAW, I_ADAB, I_NPRE, I_NPOST, I_WOUT, I_EWIN, I_SINK, I_MU, I_W0, I_W2, I_A0, I_A2, I_KK, I_KA, I_RK,
       I_LNW, I_LNB, I_OWIN, I_LQ1, I_LK1, I_LQ2, I_LK2, I_SUBLN };

__device__ __forceinline__ float wave_sum(float v) {
#pragma unroll
    for (int o = 1; o < 64; o <<= 1) v += __shfl_xor(v, o);
    return v;
}
__device__ __forceinline__ float bf2f(bf16 v) { return __builtin_bit_cast(float, (unsigned)v << 16); }
__device__ __forceinline__ float silu_f(float x) { return x / (1.f + __expf(-x)); }
__device__ __forceinline__ const float* xrow(const Params& P, int r) { return r < MP ? P.in[I_XP] + (size_t)r * D : P.in[I_XS] + (size_t)(r - MP) * D; }
__device__ __forceinline__ int modidx(int r) { return r < MP ? 0 : 1 + ((r - MP) >> 11); }

__device__ __forceinline__ void p0_transpose_item(const float* W, int K, int N, bf16* WT, LAS float* scr, int item, int lane) {
    const int nblk = N / 32, kb = item / nblk, nb = item % nblk, k0 = 64 * kb, n0 = 32 * nb;
#pragma unroll 8
    for (int i = 0; i < 32; ++i) { const int kk = 2 * i + (lane >> 5); scr[kk * 33 + (lane & 31)] = W[(size_t)(k0 + kk) * N + n0 + (lane & 31)]; }
    LDS_WAIT(); asm volatile("" ::: "memory");
    const int c = lane & 7;
#pragma unroll
    for (int j = 0; j < 4; ++j) { const int n = (lane >> 3) + 8 * j; const LAS float* s = scr + (8 * c) * 33 + n;
        v4u o; o.x = pk2(s[0 * 33], s[1 * 33]); o.y = pk2(s[2 * 33], s[3 * 33]); o.z = pk2(s[4 * 33], s[5 * 33]); o.w = pk2(s[6 * 33], s[7 * 33]);
        *(GAS v4u*)(WT + (size_t)(n0 + n) * K + k0 + 8 * c) = o; }
    LDS_WAIT(); asm volatile("" ::: "memory");
}
__device__ __forceinline__ float mod_val(const Params& P, int l, int j, int n) {
    const float* mp = (const float*)(P.ws + WS_MODP);
    float s = P.in[I_ADAB][l * 3072 + n];
#pragma unroll
    for (int kc = 0; kc < 8; ++kc) s += mp[((l * 8 + kc) * 3 + j) * 3072 + n];
    return s;
}

__device__ __forceinline__ void p0_prologue(const Params& P, LAS unsigned char* lds, int G, int vcu, int wave, int lane, int tid) {
    LAS float* scr = (LAS float*)(lds + wave * 16384);
    const int gw = vcu * NWAVES + wave, NGW = G * NWAVES;
    constexpr int I_T0 = 16 * (N0 / 32), I_TO = 16 * 32, I_T1 = 16 * (N1 / 32), I_MOD = 2 * 8 * 48;
    constexpr int NITEMS = I_T0 + 2 * I_TO + I_T1 + I_MOD;
    for (int it = gw; it < NITEMS; it += NGW) {
        int r = it;
        if (r < I_MOD) {
            const int l = r / 384, rem = r % 384, kc = rem / 48, nb = rem % 48, n = nb * 64 + lane, k0 = kc * 128;
            const float* W = P.in[I_ADAW] + ((size_t)l * 1024 + k0) * 3072 + n;
            const float* c0p = P.in[I_CCTX] + k0; const float* c1p = P.in[I_C] + k0; const float* c2p = P.in[I_C] + 1024 + k0;
            float a0 = 0.f, a1 = 0.f, a2 = 0.f;
#pragma unroll 8
            for (int kk = 0; kk < 128; ++kk) { const float w = W[(size_t)kk * 3072];
                a0 += silu_f(c0p[kk]) * w; a1 += silu_f(c1p[kk]) * w; a2 += silu_f(c2p[kk]) * w; }
            float* mp = (float*)(P.ws + WS_MODP) + (size_t)((l * 8 + kc) * 3) * 3072 + n;
            mp[0] = a0; mp[3072] = a1; mp[6144] = a2;
            continue; }
        r -= I_MOD;
        if (r < I_T0) { p0_transpose_item(P.in[I_EWIN], D, N0, (bf16*)(P.ws + WS_WT0), scr, r, lane); continue; } r -= I_T0;
        if (r < I_TO) { p0_transpose_item(P.in[I_WOUT], D, D, (bf16*)(P.ws + WS_WO0), scr, r, lane); continue; } r -= I_TO;
        if (r < I_TO) { p0_transpose_item(P.in[I_WOUT] + (size_t)D * D, D, D, (bf16*)(P.ws + WS_WO1), scr, r, lane); continue; } r -= I_TO;
        p0_transpose_item(P.in[I_OWIN], D, N1, (bf16*)(P.ws + WS_WT1), scr, r, lane);
    }
    const int gt = vcu * 512 + tid, NT = G * 512;
    { unsigned* z = (unsigned*)(P.ws + WS_WT0 + (size_t)N0 * D * 2); for (int i = gt; i < 128 * D / 2; i += NT) z[i] = 0u; }
    { const float* s0 = P.in[I_CAK]; const float* s1 = P.in[I_CAV]; const float* s2 = P.in[I_CCK]; const float* s3 = P.in[I_CCV];
      unsigned* d0 = (unsigned*)(P.ws + WS_CAK); unsigned* d1 = (unsigned*)(P.ws + WS_CAV); unsigned* d2 = (unsigned*)(P.ws + WS_CCK); unsigned* d3 = (unsigned*)(P.ws + WS_CCV);
      for (int i = gt; i < 32768; i += NT) { d0[i] = pk2(s0[2 * i], s0[2 * i + 1]); d1[i] = pk2(s1[2 * i], s1[2 * i + 1]); }
      for (int i = gt; i < 262144; i += NT) { d2[i] = pk2(s2[2 * i], s2[2 * i + 1]); d3[i] = pk2(s3[2 * i], s3[2 * i + 1]); } }
    { unsigned short* wt = (unsigned short*)(P.ws + WS_LORA); const float* w2 = P.in[I_W2]; const float* a2 = P.in[I_A2];
      for (int i = gt; i < 65536; i += NT) { const int l = i & 63, cc = (i >> 6) & 63, hh = (i >> 12) & 7, z = i >> 15; const size_t si = (size_t)(z * 64 + l) * 512 + hh * 64 + cc;
        wt[i] = (unsigned short)f2bf(w2[si]); wt[65536 + i] = (unsigned short)f2bf(a2[si]); } }
    { float* rt_ = (float*)(P.ws + WS_ROPE); for (int i = gt; i < 1024; i += NT) { const int pos = i >> 4, f = i & 15;
        const float inv = 1.0f / powf(10000.0f, (float)f / 16.0f); const float ang = (float)pos * inv; float sn, cs; sincosf(ang, &sn, &cs); rt_[2 * i] = cs; rt_[2 * i + 1] = sn; } }
}

__device__ __forceinline__ void p1_hprep(const Params& P, LAS unsigned char* lds, int G, int vcu, int wave, int lane, int tid) {
    LAS float* gs = (LAS float*)lds; LAS float* sh = gs + 3 * 1024;
    for (int i = tid; i < 3 * 1024; i += 512) { const int j = i >> 10, k = i & 1023;
        gs[i] = P.in[I_NPRE][k] * (1.f + mod_val(P, 0, j, 1024 + k)); sh[i] = mod_val(P, 0, j, k); }
    __syncthreads();
    const int gw = vcu * NWAVES + wave, NGW = G * NWAVES;
    bf16* XN = (bf16*)(P.ws + WS_XN);
    for (int r = gw; r < M; r += NGW) {
        const f32x4* xr = (const f32x4*)xrow(P, r) + lane; const int j = modidx(r);
        f32x4 v[4]; float s = 0.f;
#pragma unroll
        for (int q = 0; q < 4; ++q) { v[q] = xr[64 * q]; s += (v[q].x * v[q].x + v[q].y * v[q].y) + (v[q].z * v[q].z + v[q].w * v[q].w); }
        const float rinv = 1.f / sqrtf(wave_sum(s) * (1.f / D) + NORM_EPS);
        unsigned long long* o8 = (unsigned long long*)(XN + (size_t)r * D) + lane;
#pragma unroll
        for (int q = 0; q < 4; ++q) { const int k = 256 * q + 4 * lane; const LAS float* g = gs + j * 1024 + k; const LAS float* b = sh + j * 1024 + k;
            const float o0 = v[q].x * rinv * g[0] + b[0], o1 = v[q].y * rinv * g[1] + b[1], o2 = v[q].z * rinv * g[2] + b[2], o3 = v[q].w * rinv * g[3] + b[3];
            o8[64 * q] = (unsigned long long)pk2(o0, o1) | ((unsigned long long)pk2(o2, o3) << 32); }
    }
    __syncthreads();
}
namespace att {
using bf16x8 = __attribute__((ext_vector_type(8))) short;
using s16x4  = __attribute__((ext_vector_type(4))) short;
using f32x16 = __attribute__((ext_vector_type(16))) float;
using u32x4  = __attribute__((ext_vector_type(4))) unsigned;
constexpr float SCALE = 0.125f, CSC = 0.125f * 1.4426950408889634f, THR = 8.f;
#define ATT_SBAR() __builtin_amdgcn_sched_barrier(0)
__device__ __forceinline__ int crow(int r, int hi) { return (r & 3) + 8 * (r >> 2) + 4 * hi; }
__device__ __forceinline__ unsigned cvtpk(float lo, float hi) { unsigned r; asm volatile("v_cvt_pk_bf16_f32 %0, %1, %2" : "=v"(r) : "v"(lo), "v"(hi)); return r; }
__device__ __forceinline__ void partialSM(f32x16& p0, f32x16& p1, float& m_reg, float& alpha) {
  float pmax = p0[0];
#pragma unroll
  for (int r = 1; r < 16; ++r) pmax = fmaxf(pmax, p0[r]);
#pragma unroll
  for (int r = 0; r < 16; ++r) pmax = fmaxf(pmax, p1[r]);
  { auto rr = __builtin_amdgcn_permlane32_swap(__float_as_uint(pmax), __float_as_uint(pmax), false, false);
    pmax = fmaxf(__uint_as_float(rr[0]), __uint_as_float(rr[1])); }
  float mn;
  if (__builtin_expect(__all(pmax - m_reg <= THR / SCALE), 1)) { mn = m_reg; alpha = 1.f; }
  else { mn = fmaxf(m_reg, pmax); alpha = __builtin_amdgcn_exp2f((m_reg - mn) * CSC); m_reg = mn; }
  const float mnC = -mn * CSC;
#pragma unroll
  for (int r = 0; r < 16; ++r) p0[r] = fmaf(p0[r], CSC, mnC);
#pragma unroll
  for (int r = 0; r < 16; ++r) p1[r] = fmaf(p1[r], CSC, mnC);
#pragma unroll
  for (int r = 0; r < 16; ++r) p0[r] = __builtin_amdgcn_exp2f(p0[r]);
}
__device__ __forceinline__ void finishSM(f32x16& p0, f32x16& p1, float alpha, float& l_reg, bf16x8& pa0, bf16x8& pa1, bf16x8& pa2, bf16x8& pa3) {
#pragma unroll
  for (int r = 0; r < 16; ++r) p1[r] = __builtin_amdgcn_exp2f(p1[r]);
  float ps = 0;
#pragma unroll
  for (int r = 0; r < 16; ++r) ps += p0[r];
#pragma unroll
  for (int r = 0; r < 16; ++r) ps += p1[r];
  { auto rr = __builtin_amdgcn_permlane32_swap(__float_as_uint(ps), __float_as_uint(ps), false, false);
    ps = __uint_as_float(rr[0]) + __uint_as_float(rr[1]); }
  l_reg = l_reg * alpha + ps;
#define PK4(P, BASE, OUT) do { unsigned a0 = cvtpk(P[BASE + 0], P[BASE + 1]), a1 = cvtpk(P[BASE + 2], P[BASE + 3]);   \
    unsigned b0 = cvtpk(P[BASE + 4], P[BASE + 5]), b1 = cvtpk(P[BASE + 6], P[BASE + 7]);                              \
    auto r0 = __builtin_amdgcn_permlane32_swap(a0, b0, false, false); auto r1 = __builtin_amdgcn_permlane32_swap(a1, b1, false, false); \
    u32x4 w = {r0[0], r1[0], r0[1], r1[1]}; OUT = *reinterpret_cast<bf16x8*>(&w); } while (0)
  PK4(p0, 0, pa0); PK4(p0, 8, pa1); PK4(p1, 0, pa2); PK4(p1, 8, pa3);
#undef PK4
}
template <int KW> __device__ __forceinline__ int kswz(int row, int colB) { return row * (KW * 2) + (colB ^ ((row & 7) << 4)); }
template <int KW> __device__ __forceinline__ void qkt(f32x16& p0, f32x16& p1, const LAS unsigned char* Ks, int kcolB, const bf16x8* qr, int r32, int hi) {
  p0 = f32x16{}; p1 = f32x16{};
#pragma unroll
  for (int d0 = 0; d0 < 4; ++d0) { const int cb = kcolB + (d0 * 16 + hi * 8) * 2;
    const bf16x8 b0 = *(const LAS bf16x8*)(Ks + kswz<KW>(r32, cb));
    const bf16x8 b1 = *(const LAS bf16x8*)(Ks + kswz<KW>(32 + r32, cb));
    p0 = __builtin_amdgcn_mfma_f32_32x32x16_bf16(b0, qr[d0], p0, 0, 0, 0);
    p1 = __builtin_amdgcn_mfma_f32_32x32x16_bf16(b1, qr[d0], p1, 0, 0, 0); }
}
template <int NCB> __device__ __forceinline__ int v_st(int k, int c) { const int kk = (k & ~0xC) | ((k & 4) << 1) | ((k & 8) >> 1); return ((kk >> 3) * NCB + (c >> 5)) * 512 + ((kk & 7) * 32 + (c & 31)) * 2; }
__device__ __forceinline__ int v_rd_base(int lane) { return ((lane & 3) << 3) | (((lane >> 2) & 3) << 6) | (((lane >> 4) & 1) << 5) | (((lane >> 5) & 1) << 8); }
template <int NCB> constexpr int v_rd_off(int d0, int ks, int half) { return d0 * 512 + ks * (2 * NCB * 512) + half * (NCB * 512); }
template <int OFF> __device__ __forceinline__ s16x4 tr_read(int vb) { s16x4 r; asm volatile("ds_read_b64_tr_b16 %0, %1 offset:%2" : "=&v"(r) : "v"(vb), "i"(OFF) : "memory"); return r; }
template <int NCB, int D0> __device__ __forceinline__ void pv_one(f32x16& od, int vb, bf16x8 pa0, bf16x8 pa1, bf16x8 pa2, bf16x8 pa3) {
  const s16x4 l0 = tr_read<v_rd_off<NCB>(D0, 0, 0)>(vb), h0 = tr_read<v_rd_off<NCB>(D0, 0, 1)>(vb), l1 = tr_read<v_rd_off<NCB>(D0, 1, 0)>(vb), h1 = tr_read<v_rd_off<NCB>(D0, 1, 1)>(vb);
  const s16x4 l2 = tr_read<v_rd_off<NCB>(D0, 2, 0)>(vb), h2 = tr_read<v_rd_off<NCB>(D0, 2, 1)>(vb), l3 = tr_read<v_rd_off<NCB>(D0, 3, 0)>(vb), h3 = tr_read<v_rd_off<NCB>(D0, 3, 1)>(vb);
  asm volatile("s_waitcnt lgkmcnt(0)" ::: "memory"); ATT_SBAR();
#define PK(L, H) (bf16x8){L[0], L[1], L[2], L[3], H[0], H[1], H[2], H[3]}
  od = __builtin_amdgcn_mfma_f32_32x32x16_bf16(pa0, PK(l0, h0), od, 0, 0, 0);
  od = __builtin_amdgcn_mfma_f32_32x32x16_bf16(pa1, PK(l1, h1), od, 0, 0, 0);
  od = __builtin_amdgcn_mfma_f32_32x32x16_bf16(pa2, PK(l2, h2), od, 0, 0, 0);
  od = __builtin_amdgcn_mfma_f32_32x32x16_bf16(pa3, PK(l3, h3), od, 0, 0, 0);
#undef PK
}
struct Src { const bf16* kc; const bf16* vc; int cp; const bf16* kl; const bf16* vl; int lp; int nctx; int nt; int lat0; int q0; bool mask; };
constexpr int L_K = 0, L_V = 16384, L_WS = 32768, L_CMB = 65536;

template <int KW, int DV, bool ZS>
__device__ __forceinline__ void attn_unit(LAS unsigned char* lds, const bf16* Qrow0  , int qpitch, const Src& S,
                                          float sink_l2  , float lam, f32x16* o, int tid, int wave, int lane) {
  constexpr int NCB = DV / 32, NPK = KW / 64, NPV = DV / 64;
  const int r32 = lane & 31, hi = lane >> 5;
  const int qoff = ZS ? 32 * (wave >> 1) : 32 * wave; const int kcolB = ZS ? (wave & 1) * 128 : 0;
  LAS float* wsf = (LAS float*)(lds + L_WS) + wave * 64; LAS float* li_l = wsf; LAS float* al_l = wsf + 32;
  float m_reg = -1e30f, l_reg = 0.f;
#pragma unroll
  for (int d = 0; d < NCB; ++d) o[d] = f32x16{};
  bf16x8 qr[4];
  { const bf16* Qw = Qrow0 + (size_t)(qoff + r32) * qpitch + (ZS ? (wave & 1) * 64 : 0) + hi * 8;
#pragma unroll
    for (int d0 = 0; d0 < 4; ++d0) qr[d0] = *(const bf16x8*)(Qw + d0 * 16); }
  const int ksr = (KW == 64) ? (tid >> 3) : (tid >> 4), ksc = (KW == 64) ? (tid & 7) * 8 : (tid & 15) * 8;
  const int vsr = (DV == 64) ? (tid >> 3) : (tid >> 4), vsc = (DV == 64) ? (tid & 7) * 8 : (tid & 15) * 8;
  const int vb0 = (int)(size_t)(lds + L_V) + v_rd_base(lane);
  bf16x8 kst[NPK], vst[NPV];
#define ATT_LOAD(j) do { const bool cx = (j) < S.nctx; const bf16* kb = cx ? S.kc + (size_t)((j) * 64) * S.cp : S.kl + (size_t)(S.lat0 + ((j) - S.nctx) * 64) * S.lp; \
    const bf16* vbp = cx ? S.vc + (size_t)((j) * 64) * S.cp : S.vl + (size_t)(S.lat0 + ((j) - S.nctx) * 64) * S.lp; const int pt = cx ? S.cp : S.lp; \
    _Pragma("unroll") for (int i = 0; i < NPK; ++i) kst[i] = *(const bf16x8*)(kb + (size_t)(ksr + 32 * i) * pt + ksc); \
    _Pragma("unroll") for (int i = 0; i < NPV; ++i) vst[i] = *(const bf16x8*)(vbp + (size_t)(vsr + 32 * i) * pt + vsc); } while (0)
#define ATT_WRITE() do { \
    _Pragma("unroll") for (int i = 0; i < NPK; ++i) *(LAS bf16x8*)(lds + L_K + kswz<KW>(ksr + 32 * i, ksc * 2)) = kst[i]; \
    _Pragma("unroll") for (int i = 0; i < NPV; ++i) *(LAS bf16x8*)(lds + L_V + v_st<NCB>(vsr + 32 * i, vsc)) = vst[i]; } while (0)
  ATT_LOAD(0);
  for (int j = 0; j < S.nt; ++j) {
    __syncthreads();
    ATT_WRITE();
    __syncthreads();
    if (j + 1 < S.nt) ATT_LOAD(j + 1);
    f32x16 p0, p1; float alpha; bf16x8 pa0, pa1, pa2, pa3;
    ATT_SBAR(); qkt<KW>(p0, p1, lds + L_K, kcolB, qr, r32, hi);
    if (S.mask && j >= S.nctx) {
      const int qpos = S.q0 + qoff + r32, kb0 = S.lat0 + (j - S.nctx) * 64;
#pragma unroll
      for (int r = 0; r < 16; ++r) { const int k0 = kb0 + crow(r, hi) - qpos; if (k0 > 128 || k0 < -128) p0[r] = -1e30f; const int k1 = k0 + 32; if (k1 > 128 || k1 < -128) p1[r] = -1e30f; }
    }
    partialSM(p0, p1, m_reg, alpha);
    if (__any(alpha < 1.f)) { if (hi == 0) al_l[r32] = alpha; asm volatile("s_waitcnt lgkmcnt(0)" ::: "memory");
#pragma unroll
      for (int d = 0; d < NCB; ++d)
#pragma unroll
        for (int r = 0; r < 16; ++r) o[d][r] *= al_l[crow(r, hi)]; }
    finishSM(p0, p1, alpha, l_reg, pa0, pa1, pa2, pa3); ATT_SBAR();
    pv_one<NCB, 0>(o[0], vb0, pa0, pa1, pa2, pa3); pv_one<NCB, 1>(o[1], vb0, pa0, pa1, pa2, pa3);
    if constexpr (NCB == 4) { pv_one<NCB, 2>(o[2], vb0, pa0, pa1, pa2, pa3); pv_one<NCB, 3>(o[3], vb0, pa0, pa1, pa2, pa3); }
  }
#undef ATT_LOAD
#undef ATT_WRITE
  float lt = l_reg + __builtin_amdgcn_exp2f(sink_l2 - m_reg * CSC);
  if (hi == 0) li_l[r32] = lt; asm volatile("s_waitcnt lgkmcnt(0)" ::: "memory");
  float rli[16];
#pragma unroll
  for (int r = 0; r < 16; ++r) rli[r] = __builtin_amdgcn_rcpf(li_l[crow(r, hi)]);
#pragma unroll
  for (int d = 0; d < NCB; ++d)
#pragma unroll
    for (int r = 0; r < 16; ++r) o[d][r] *= rli[r];
  if constexpr (ZS) {
    LAS float* cb = (LAS float*)(lds + L_CMB) + (wave >> 1) * 4096;
    if (wave & 1) {
#pragma unroll
      for (int d = 0; d < NCB; ++d)
#pragma unroll
        for (int r = 0; r < 16; ++r) cb[(d * 16 + r) * 64 + lane] = o[d][r];
    }
    __syncthreads();
    if (!(wave & 1)) {
#pragma unroll
      for (int d = 0; d < NCB; ++d)
#pragma unroll
        for (int r = 0; r < 16; ++r) o[d][r] -= lam * cb[(d * 16 + r) * 64 + lane];
    }
  }
}
#undef ATT_SBAR
}
namespace rw {
typedef short bf16x8 __attribute__((ext_vector_type(8)));
typedef short bf16x4 __attribute__((ext_vector_type(4)));
typedef float f32x4 __attribute__((ext_vector_type(4)));
constexpr int R_KK = 0, R_RR = 2048, R_GG = 4096, R_VP = 8192, R_AKK = 10240, R_TI = 11264, R_MR = 12288, R_WC = 13312, REC_BYTES = 13568;
constexpr int S_R = 0, S_K = 4096, S_V = 8192, S_TW = 12288, S_AL = 14336, A_K = 16384, A_R = 18432, A_B = 20480, A_E = 22528, S_NT = 24576, S_RED = 25600, SCR_BYTES = 26624;
__device__ __forceinline__ unsigned short f2b(float f) { unsigned u = __builtin_bit_cast(unsigned, f); return (unsigned short)((u + 0x7fffu + ((u >> 16) & 1u)) >> 16); }
__device__ __forceinline__ bf16x4 pack4(float a, float b, float c, float d) { bf16x4 r; r[0] = (short)f2b(a); r[1] = (short)f2b(b); r[2] = (short)f2b(c); r[3] = (short)f2b(d); return r; }

struct Consts { float mu_r, mu_k, mu_v, mu_w, mu_a, w0c, a0c, kkc, kac, rkc; bf16x8 w2f[2], a2f[2]; };
__device__ __forceinline__ void load_consts(const Params& P, int h, int dir, int gtid, int lane, Consts& K, float& w0s, float& a0s, float& kks, float& kas, float& rks) {
    const int c = gtid & 63, hc = h * 64 + c; const float* mu = P.in[I_MU];
    K.mu_r = mu[hc]; K.mu_k = mu[512 + hc]; K.mu_v = mu[1024 + hc]; K.mu_w = mu[1536 + c]; K.mu_a = mu[1600 + c];
    const int wq = (gtid >> 6), l15 = lane & 15, g = lane >> 4, c2 = h * 64 + 16 * wq + l15;
    w0s = P.in[I_W0][dir * 512 + c2]; a0s = P.in[I_A0][dir * 512 + c2]; kks = P.in[I_KK][c2]; kas = P.in[I_KA][c2]; rks = P.in[I_RK][c2];
    const bf16* w2t = (const bf16*)(P.ws + WS_LORA) + ((size_t)(dir * 8 + h) * 64 + 16 * wq + l15) * 64; const bf16* a2t = w2t + 65536;
#pragma unroll
    for (int ks = 0; ks < 2; ++ks) { K.w2f[ks] = *(const bf16x8*)(w2t + 32 * ks + 8 * g); K.a2f[ks] = *(const bf16x8*)(a2t + 32 * ks + 8 * g); }
}
__device__ __forceinline__ void prep_chunk(const Params& P, LAS unsigned char* rec, LAS unsigned char* scr, int rowbase, int T, int t0, int h, int dir, const Consts& K,
                                           float w0s, float a0s, float kks, float kas, float rks, float* bon_out, int bon_stride, int gtid, int lane) {
    const bf16* PR = (const bf16*)(P.ws + WS_PROJ);
    const int c = gtid & 63, wq = gtid >> 6, l15 = lane & 15, g = lane >> 4, hc = h * 64 + c;
    LAS float* sR = (LAS float*)(scr + S_R); LAS float* sK = (LAS float*)(scr + S_K); LAS float* sV = (LAS float*)(scr + S_V);
    LAS unsigned short* sTW = (LAS unsigned short*)(scr + S_TW); LAS unsigned short* sAL = (LAS unsigned short*)(scr + S_AL);
    LAS unsigned short* aK = (LAS unsigned short*)(scr + A_K); LAS unsigned short* aR = (LAS unsigned short*)(scr + A_R);
    LAS unsigned short* aB = (LAS unsigned short*)(scr + A_B); LAS unsigned short* aE = (LAS unsigned short*)(scr + A_E);
    LAS float* sNT = (LAS float*)(scr + S_NT); LAS float* red = (LAS float*)(scr + S_RED);
    {   float pv[6][5];
        const int base = dir ? t0 + 12 - 4 * wq : t0 + 4 * wq;
#pragma unroll
        for (int i = 0; i < 6; ++i) { const int t = base - 1 + i; const bool ok = (t >= 0) && (t < T); const bf16* pr = PR + (size_t)(rowbase + (ok ? t : 0)) * N0 + 1280;
            pv[i][0] = ok ? bf2f(pr[hc]) : 0.f; pv[i][1] = ok ? bf2f(pr[512 + hc]) : 0.f; pv[i][2] = ok ? bf2f(pr[1024 + hc]) : 0.f;
            pv[i][3] = ok ? bf2f(pr[1536 + c]) : 0.f; pv[i][4] = ok ? bf2f(pr[1600 + c]) : 0.f; }
        float xv4[4];
#pragma unroll
        for (int i = 0; i < 4; ++i) { const int tl = 4 * wq + i; const int ix = dir ? 4 - i : 1 + i;
            const float xr = pv[ix][0] + (0.5f * (pv[ix - 1][0] + pv[ix + 1][0]) - pv[ix][0]) * K.mu_r;
            const float xk = pv[ix][1] + (0.5f * (pv[ix - 1][1] + pv[ix + 1][1]) - pv[ix][1]) * K.mu_k;
            const float xv = pv[ix][2] + (0.5f * (pv[ix - 1][2] + pv[ix + 1][2]) - pv[ix][2]) * K.mu_v;
            const float xw = pv[ix][3] + (0.5f * (pv[ix - 1][3] + pv[ix + 1][3]) - pv[ix][3]) * K.mu_w;
            const float xa = pv[ix][4] + (0.5f * (pv[ix - 1][4] + pv[ix + 1][4]) - pv[ix][4]) * K.mu_a;
            sR[tl * 64 + c] = xr; sK[tl * 64 + c] = xk; sV[tl * 64 + c] = xv; xv4[i] = xv; sTW[tl * 64 + c] = f2b(tanhf(xw)); sAL[tl * 64 + c] = f2b(xa); }
        *(LAS bf16x4*)(rec + R_VP + (c * 4 + wq) * 8) = pack4(xv4[0], xv4[1], xv4[2], xv4[3]); }
    __syncthreads();
    const int ch = 16 * wq + l15;
    float e[4], av[4], kv[4], rv[4], kkr[4], ke[4], cum[4];
    {   f32x4 wp = {0.f, 0.f, 0.f, 0.f}, ap = {0.f, 0.f, 0.f, 0.f};
#pragma unroll
        for (int ks = 0; ks < 2; ++ks) { const bf16x8 ta = *(const LAS bf16x8*)(sTW + l15 * 64 + 32 * ks + 8 * g), aa = *(const LAS bf16x8*)(sAL + l15 * 64 + 32 * ks + 8 * g);
            wp = __builtin_amdgcn_mfma_f32_16x16x32_bf16(ta, K.w2f[ks], wp, 0, 0, 0); ap = __builtin_amdgcn_mfma_f32_16x16x32_bf16(aa, K.a2f[ks], ap, 0, 0, 0); }
        float ssq[4], bs[4];
#pragma unroll
        for (int i = 0; i < 4; ++i) { const int tl = 4 * g + i;
            const float wl = -(w0s + wp[i]); const float sp = fmaxf(wl, 0.f) + log1pf(__expf(-fabsf(wl)));
            e[i] = __expf(-sp - 0.5f);
            av[i] = 1.f / (1.f + __expf(-(a0s + ap[i])));
            kv[i] = sK[tl * 64 + ch]; rv[i] = sR[tl * 64 + ch];
            kkr[i] = kv[i] * kks; ke[i] = kv[i] * (1.f + (av[i] - 1.f) * kas);
            ssq[i] = kkr[i] * kkr[i]; bs[i] = rv[i] * ke[i] * rks; }
#pragma unroll
        for (int i = 0; i < 4; ++i) {
#pragma unroll
            for (int o = 1; o < 16; o <<= 1) { ssq[i] += __shfl_xor(ssq[i], o); bs[i] += __shfl_xor(bs[i], o); }
            if (l15 == 0) { red[wq * 16 + 4 * g + i] = ssq[i]; red[64 + wq * 16 + 4 * g + i] = bs[i]; } }
        cum[0] = e[0]; cum[1] = cum[0] + e[1]; cum[2] = cum[1] + e[2]; cum[3] = cum[2] + e[3];
        const float tot = cum[3];
        const float t0s = __shfl(tot, l15), t1s = __shfl(tot, l15 + 16), t2s = __shfl(tot, l15 + 32), t3s = __shfl(tot, l15 + 48);
        const float pre = (g > 0 ? t0s : 0.f) + (g > 1 ? t1s : 0.f) + (g > 2 ? t2s : 0.f);
#pragma unroll
        for (int i = 0; i < 4; ++i) cum[i] += pre;
        if (g == 0) *(LAS float*)(rec + R_WC + ch * 4) = __expf(-(t0s + t1s + t2s + t3s)); }
    __syncthreads();
    {   const int ks = ch >> 5, hb = (ch >> 4) & 1, gk = (ch >> 2) & 3, ik = ch & 3;
        LAS unsigned short* KKp = (LAS unsigned short*)(rec + R_KK); LAS unsigned short* RRp = (LAS unsigned short*)(rec + R_RR);
        float bt[4], et[4];
#pragma unroll
        for (int i = 0; i < 4; ++i) { const int tl = 4 * g + i;
            const float nrm = sqrtf(red[tl] + red[16 + tl] + red[32 + tl] + red[48 + tl]); const float kk = kkr[i] / fmaxf(nrm, 1e-12f);
            const float Wt = __expf(-cum[i]), Wp = __expf(-(cum[i] - e[i])), iW = __expf(cum[i]);
            const float ktv = kk * Wp, rtv = rv[i] * Wt; bt[i] = kk * av[i] * iW; et[i] = ke[i] * iW;
            const unsigned short kb = f2b(ktv), rb = f2b(rtv);
            aK[tl * 64 + ch] = kb; aR[tl * 64 + ch] = rb; aB[tl * 64 + ch] = f2b(bt[i]); aE[tl * 64 + ch] = f2b(et[i]);
            KKp[((tl * 2 + ks) * 4 + gk) * 8 + 4 * hb + ik] = kb; RRp[((tl * 2 + ks) * 4 + gk) * 8 + 4 * hb + ik] = rb; }
        *(LAS bf16x4*)(rec + R_GG + (ch * 4 + g) * 16) = pack4(bt[0], bt[1], bt[2], bt[3]);
        *(LAS bf16x4*)(rec + R_GG + (ch * 4 + g) * 16 + 8) = pack4(et[0], et[1], et[2], et[3]);
        if (wq == 0 && lane < 16) bon_out[lane * bon_stride] = red[64 + lane] + red[80 + lane] + red[96 + lane] + red[112 + lane]; }
    __syncthreads();
    {   const LAS unsigned short* ra = (wq & 1) ? aE : aB; const LAS unsigned short* cb = (wq < 2) ? aK : aR;
        f32x4 acc = {0.f, 0.f, 0.f, 0.f};
#pragma unroll
        for (int ks = 0; ks < 2; ++ks) { const bf16x8 fa = *(const LAS bf16x8*)(ra + l15 * 64 + 32 * ks + 8 * g), fb = *(const LAS bf16x8*)(cb + l15 * 64 + 32 * ks + 8 * g);
            acc = __builtin_amdgcn_mfma_f32_16x16x32_bf16(fa, fb, acc, 0, 0, 0); }
#pragma unroll
        for (int i = 0; i < 4; ++i) { const int s = 4 * g + i; const bool keep = (wq < 2) ? (s < l15) : (s <= l15); if (!keep) acc[i] = 0.f; }
        if (wq == 0) { *(LAS f32x4*)(sNT + l15 * 16 + 4 * g) = acc; *(LAS bf16x4*)(rec + R_TI + (l15 * 4 + g) * 16 + 8) = pack4(0.f, 0.f, 0.f, 0.f); }
        else if (wq == 1) { *(LAS bf16x4*)(rec + R_AKK + (l15 * 4 + g) * 16) = pack4(0.f, 0.f, 0.f, 0.f); *(LAS bf16x4*)(rec + R_AKK + (l15 * 4 + g) * 16 + 8) = pack4(acc[0], acc[1], acc[2], acc[3]); }
        else if (wq == 2) *(LAS bf16x4*)(rec + R_MR + (l15 * 4 + g) * 16) = pack4(acc[0], acc[1], acc[2], acc[3]);
        else *(LAS bf16x4*)(rec + R_MR + (l15 * 4 + g) * 16 + 8) = pack4(acc[0], acc[1], acc[2], acc[3]); }
    __syncthreads();
    if (wq == 0 && lane < 16) {
        float x[16];
        const float lf = (float)lane;
#pragma unroll
        for (int t = 0; t < 16; ++t) { float s = 1.f - fminf(fabsf(lf - (float)t), 1.f);
#pragma unroll
            for (int q = 0; q < 4; ++q) { if (4 * q < t) { const f32x4 n4 = *(const LAS f32x4*)(sNT + t * 16 + 4 * q);
#pragma unroll
                for (int j = 0; j < 4; ++j) if (4 * q + j < t) s -= x[4 * q + j] * n4[j]; } }
            x[t] = s; }
        LAS unsigned short* TI = (LAS unsigned short*)(rec + R_TI);
#pragma unroll
        for (int t = 0; t < 16; ++t) TI[(t * 4 + (lane >> 2)) * 8 + (lane & 3)] = f2b(-x[t]);
    }
    __syncthreads();
}
__device__ __forceinline__ void scan_chunk(const LAS unsigned char* rec, f32x4 (&acc)[4], float* ydst, int ystep, int wq, int lane) {
    const int l15 = lane & 15, g = lane >> 4;
    const bf16x8 kk0 = *(const LAS bf16x8*)(rec + R_KK + l15 * 128 + g * 16), kk1 = *(const LAS bf16x8*)(rec + R_KK + l15 * 128 + 64 + g * 16);
    const bf16x8 rr0 = *(const LAS bf16x8*)(rec + R_RR + l15 * 128 + g * 16), rr1 = *(const LAS bf16x8*)(rec + R_RR + l15 * 128 + 64 + g * 16);
    const bf16x8 akk = *(const LAS bf16x8*)(rec + R_AKK + (l15 * 4 + g) * 16), ti = *(const LAS bf16x8*)(rec + R_TI + (l15 * 4 + g) * 16), mr = *(const LAS bf16x8*)(rec + R_MR + (l15 * 4 + g) * 16);
    const bf16x4 vp = *(const LAS bf16x4*)(rec + R_VP + ((16 * wq + l15) * 4 + g) * 8);
    bf16x8 sf0, sf1;
    { const bf16x4 a = pack4(acc[0][0], acc[0][1], acc[0][2], acc[0][3]), b = pack4(acc[1][0], acc[1][1], acc[1][2], acc[1][3]);
      const bf16x4 c = pack4(acc[2][0], acc[2][1], acc[2][2], acc[2][3]), d = pack4(acc[3][0], acc[3][1], acc[3][2], acc[3][3]);
      sf0 = (bf16x8){a[0], a[1], a[2], a[3], b[0], b[1], b[2], b[3]}; sf1 = (bf16x8){c[0], c[1], c[2], c[3], d[0], d[1], d[2], d[3]}; }
    const bf16x8 v0 = (bf16x8){0, 0, 0, 0, vp[0], vp[1], vp[2], vp[3]};
    f32x4 X = {0.f, 0.f, 0.f, 0.f}, Y = {0.f, 0.f, 0.f, 0.f};
    X = __builtin_amdgcn_mfma_f32_16x16x32_bf16(kk0, sf0, X, 0, 0, 0); X = __builtin_amdgcn_mfma_f32_16x16x32_bf16(kk1, sf1, X, 0, 0, 0); X = __builtin_amdgcn_mfma_f32_16x16x32_bf16(akk, v0, X, 0, 0, 0);
    Y = __builtin_amdgcn_mfma_f32_16x16x32_bf16(rr0, sf0, Y, 0, 0, 0); Y = __builtin_amdgcn_mfma_f32_16x16x32_bf16(rr1, sf1, Y, 0, 0, 0);
    const bf16x4 xb = pack4(X[0], X[1], X[2], X[3]);
    const bf16x8 xf = (bf16x8){xb[0], xb[1], xb[2], xb[3], 0, 0, 0, 0};
    f32x4 U = {0.f, 0.f, 0.f, 0.f};
    U = __builtin_amdgcn_mfma_f32_16x16x32_bf16(ti, xf, U, 0, 0, 0);
    const bf16x4 ub = pack4(U[0], U[1], U[2], U[3]);
    const bf16x8 uv = (bf16x8){ub[0], ub[1], ub[2], ub[3], vp[0], vp[1], vp[2], vp[3]};
    Y = __builtin_amdgcn_mfma_f32_16x16x32_bf16(mr, uv, Y, 0, 0, 0);
#pragma unroll
    for (int mt = 0; mt < 4; ++mt) { const bf16x8 gg = *(const LAS bf16x8*)(rec + R_GG + ((16 * mt + l15) * 4 + g) * 16); const f32x4 wc = *(const LAS f32x4*)(rec + R_WC + (16 * mt + 4 * g) * 4);
        acc[mt] = __builtin_amdgcn_mfma_f32_16x16x32_bf16(gg, uv, acc[mt], 0, 0, 0); acc[mt] = acc[mt] * wc; }
#pragma unroll
    for (int i = 0; i < 4; ++i) ydst[(ptrdiff_t)(4 * g + i) * ystep + 16 * wq + l15] = Y[i];
}
__device__ __forceinline__ void post_unit(const Params& P, int rowbase, int T, int h, const float* bonf, const float* bonb, int wave, int lane) {
    const bf16* PR = (const bf16*)(P.ws + WS_PROJ); bf16* MIX = (bf16*)(P.ws + WS_MIX);
    const float* YF = (const float*)(P.ws + WS_YF); const float* YB = (const float*)(P.ws + WS_YB);
    const int hc = h * 64 + lane; const float lnw = P.in[I_LNW][hc], lnb = P.in[I_LNB][hc], muv = P.in[I_MU][1024 + hc];
    for (int t = wave; t < T; t += NWAVES) { const int r = rowbase + t;
        const float y = YF[(size_t)r * 512 + hc] + YB[(size_t)r * 512 + hc];
        const float mean = wave_sum(y) * (1.f / 64.f); const float d = y - mean; const float var = wave_sum(d * d) * (1.f / 64.f);
        const float yn = d * (1.f / sqrtf(var + 64e-5f)) * lnw + lnb;
        const bf16* p0 = PR + (size_t)r * N0; const bool hp = t > 0, hn = t + 1 < T;
        const float pc = bf2f(p0[2304 + hc]), pvp = hp ? bf2f(p0[2304 + hc - N0]) : 0.f, pvn = hn ? bf2f(p0[2304 + hc + N0]) : 0.f;
        const float xv = pc + (0.5f * (pvp + pvn) - pc) * muv;
        const float bon = 0.5f * (bonf[t] + bonb[t]);
        const float gb = bf2f(p0[2944 + hc]);
        MIX[(size_t)r * D + 512 + hc] = (bf16)f2bf((yn + bon * xv) * silu_f(gb)); }
}
}
__device__ __forceinline__ void p6_mid(const Params& P, LAS unsigned char* lds, int G, int vcu, int wave, int lane, int tid) {
    LAS float* gp = (LAS float*)lds; LAS float* gs = gp + 3 * 1024; LAS float* sh = gs + 3 * 1024;
    for (int i = tid; i < 3 * 1024; i += 512) { const int j = i >> 10, k = i & 1023;
        gp[i] = mod_val(P, 0, j, 2048 + k) * P.in[I_NPOST][k];
        gs[i] = P.in[I_NPRE][1024 + k] * (1.f + mod_val(P, 1, j, 1024 + k)); sh[i] = mod_val(P, 1, j, k); }
    __syncthreads();
    const int gw = vcu * NWAVES + wave, NGW = G * NWAVES;
    bf16* XN = (bf16*)(P.ws + WS_XN); const float* Y = (const float*)(P.ws + WS_Y);
    for (int r = gw; r < M; r += NGW) {
        const f32x4* xr = (const f32x4*)xrow(P, r) + lane; const f32x4* yr = (const f32x4*)(Y + (size_t)r * D) + lane; const int j = modidx(r);
        f32x4 y[4], x[4]; float s = 0.f;
#pragma unroll
        for (int q = 0; q < 4; ++q) { y[q] = yr[64 * q]; x[q] = xr[64 * q]; s += (y[q].x * y[q].x + y[q].y * y[q].y) + (y[q].z * y[q].z + y[q].w * y[q].w); }
        const float rinv = 1.f / sqrtf(wave_sum(s) * (1.f / D) + NORM_EPS);
        float s1 = 0.f; f32x4* orow = (f32x4*)(P.out + OUT_Y + (size_t)r * D) + lane;
#pragma unroll
        for (int q = 0; q < 4; ++q) { const LAS float* g = gp + j * 1024 + 256 * q + 4 * lane;
            x[q].x += g[0] * y[q].x * rinv; x[q].y += g[1] * y[q].y * rinv; x[q].z += g[2] * y[q].z * rinv; x[q].w += g[3] * y[q].w * rinv;
            orow[64 * q] = x[q]; s1 += (x[q].x * x[q].x + x[q].y * x[q].y) + (x[q].z * x[q].z + x[q].w * x[q].w); }
        const float rinv1 = 1.f / sqrtf(wave_sum(s1) * (1.f / D) + NORM_EPS);
        unsigned long long* o8 = (unsigned long long*)(XN + (size_t)r * D) + lane;
#pragma unroll
        for (int q = 0; q < 4; ++q) { const int k = 256 * q + 4 * lane; const LAS float* g = gs + j * 1024 + k; const LAS float* b = sh + j * 1024 + k;
            const float o0 = x[q].x * rinv1 * g[0] + b[0], o1 = x[q].y * rinv1 * g[1] + b[1], o2 = x[q].z * rinv1 * g[2] + b[2], o3 = x[q].w * rinv1 * g[3] + b[3];
            o8[64 * q] = (unsigned long long)pk2(o0, o1) | ((unsigned long long)pk2(o2, o3) << 32); }
    }
    __syncthreads();
}
__device__ __forceinline__ void p10_final(const Params& P, LAS unsigned char* lds, int G, int vcu, int wave, int lane, int tid) {
    LAS float* gp = (LAS float*)lds;
    for (int i = tid; i < 3 * 1024; i += 512) { const int j = i >> 10, k = i & 1023; gp[i] = mod_val(P, 1, j, 2048 + k) * P.in[I_NPOST][1024 + k]; }
    __syncthreads();
    const int gw = vcu * NWAVES + wave, NGW = G * NWAVES;
    const float* Y = (const float*)(P.ws + WS_Y);
    for (int r = gw; r < M; r += NGW) {
        f32x4* orow = (f32x4*)(P.out + OUT_Y + (size_t)r * D) + lane; const f32x4* yr = (const f32x4*)(Y + (size_t)r * D) + lane; const int j = modidx(r);
        f32x4 y[4], x[4]; float s = 0.f;
#pragma unroll
        for (int q = 0; q < 4; ++q) { y[q] = yr[64 * q]; x[q] = orow[64 * q]; s += (y[q].x * y[q].x + y[q].y * y[q].y) + (y[q].z * y[q].z + y[q].w * y[q].w); }
        const float rinv = 1.f / sqrtf(wave_sum(s) * (1.f / D) + NORM_EPS);
#pragma unroll
        for (int q = 0; q < 4; ++q) { const LAS float* g = gp + j * 1024 + 256 * q + 4 * lane;
            x[q].x += g[0] * y[q].x * rinv; x[q].y += g[1] * y[q].y * rinv; x[q].z += g[2] * y[q].z * rinv; x[q].w += g[3] * y[q].w * rinv;
            orow[64 * q] = x[q]; }
    }
    __syncthreads();
}
__device__ __forceinline__ void attnA_unit(const Params& P, LAS unsigned char* lds, bool sample, int b, int h, int qb, int tid, int wave, int lane) {
    asm volatile("" : "+v"(tid), "+v"(lane));
    const bf16* PR = (const bf16*)(P.ws + WS_PROJ); bf16* MIX = (bf16*)(P.ws + WS_MIX);
    const int g = h >> 2; att::Src S; int rowQ0;
    if (sample) { rowQ0 = MP + b * 2048 + qb * 256;
        S.kc = (const bf16*)(P.ws + WS_CAK) + (size_t)b * 256 * 128 + g * 64; S.vc = (const bf16*)(P.ws + WS_CAV) + (size_t)b * 256 * 128 + g * 64; S.cp = 128; S.nctx = 4;
        S.kl = PR + (size_t)(MP + b * 2048) * N0 + 512 + g * 64; S.vl = PR + (size_t)(MP + b * 2048) * N0 + 640 + g * 64; S.lp = N0;
        const int k0 = qb * 256 - 128 < 0 ? 0 : qb * 256 - 128, k1 = qb * 256 + 384 > 2048 ? 2048 : qb * 256 + 384;
        S.lat0 = k0; S.nt = 4 + (k1 - k0) / 64; S.q0 = qb * 256; S.mask = true;
    } else { rowQ0 = b * 256;
        S.kc = nullptr; S.vc = nullptr; S.cp = 0; S.nctx = 0; S.kl = PR + (size_t)(b * 256) * N0 + 512 + g * 64; S.vl = PR + (size_t)(b * 256) * N0 + 640 + g * 64; S.lp = N0;
        S.lat0 = 0; S.nt = 4; S.q0 = 0; S.mask = false; }
    att::f32x16 o[2];
    att::attn_unit<64, 64, false>(lds, PR + (size_t)rowQ0 * N0 + h * 64, N0, S, P.in[I_SINK][h] * 1.4426950408889634f, 0.f, o, tid, wave, lane);
    const int r32 = lane & 31, hi = lane >> 5;
#pragma unroll
    for (int r = 0; r < 16; ++r) { const int row = rowQ0 + 32 * wave + att::crow(r, hi);
#pragma unroll
        for (int d = 0; d < 2; ++d) { const int col = h * 64 + 32 * d + r32; const float ga = bf2f(PR[(size_t)row * N0 + 768 + col]);
            MIX[(size_t)row * D + col] = (bf16)f2bf(o[d][r] * silu_f(ga)); } }
}
__device__ __forceinline__ void attnC_unit(const Params& P, LAS unsigned char* lds, bool sample, int b, int h, int qb, float lam, int tid, int wave, int lane) {
    asm volatile("" : "+v"(tid), "+v"(lane));
    const bf16* PR = (const bf16*)(P.ws + WS_PROJ); bf16* MIX = (bf16*)(P.ws + WS_MIX);
    att::Src S; int rowQ0;
    if (sample) { rowQ0 = MP + b * 2048 + qb * 128;
        S.kc = (const bf16*)(P.ws + WS_CCK) + (size_t)b * 256 * 1024 + h * 128; S.vc = (const bf16*)(P.ws + WS_CCV) + (size_t)b * 256 * 1024 + h * 128; S.cp = 1024; S.nctx = 4;
        S.kl = PR + (size_t)(MP + b * 2048) * N1 + 1024 + h * 128; S.vl = PR + (size_t)(MP + b * 2048) * N1 + 2048 + h * 128; S.lp = N1; S.lat0 = 0; S.nt = 36; S.q0 = qb * 128; S.mask = false;
    } else { rowQ0 = b * 256 + qb * 128;
        S.kc = nullptr; S.vc = nullptr; S.cp = 0; S.nctx = 0; S.kl = PR + (size_t)(b * 256) * N1 + 1024 + h * 128; S.vl = PR + (size_t)(b * 256) * N1 + 2048 + h * 128; S.lp = N1;
        S.lat0 = 0; S.nt = 4; S.q0 = qb * 128; S.mask = false; }
    att::f32x16 o[4];
    att::attn_unit<128, 128, true>(lds, PR + (size_t)rowQ0 * N1 + h * 128, N1, S, -INFINITY, lam, o, tid, wave, lane);
    if (!(wave & 1)) {
        const int r32 = lane & 31, hi = lane >> 5; const float sc = 1.f - 0.35550906759f;
        float rs[16];
#pragma unroll
        for (int r = 0; r < 16; ++r) { float s = o[0][r] * o[0][r] + o[1][r] * o[1][r] + o[2][r] * o[2][r] + o[3][r] * o[3][r];
            s += __shfl_xor(s, 1); s += __shfl_xor(s, 2); s += __shfl_xor(s, 4); s += __shfl_xor(s, 8); s += __shfl_xor(s, 16);
            rs[r] = sc / sqrtf(s * (1.f / 128.f) + 1e-5f); }
#pragma unroll
        for (int r = 0; r < 16; ++r) { const int row = rowQ0 + 32 * (wave >> 1) + att::crow(r, hi);
#pragma unroll
            for (int d = 0; d < 4; ++d) { const int cc = 32 * d + r32; const float gc = bf2f(PR[(size_t)row * N1 + 3072 + h * 128 + cc]);
                MIX[(size_t)row * D + h * 128 + cc] = (bf16)f2bf(o[d][r] * rs[r] * P.in[I_SUBLN][cc] * silu_f(gc)); } }
    }
}
constexpr int RW_SCR0 = 32768, RW_BON = 90112;
__device__ __forceinline__ void rw_prep_item_sample(const Params& P, LAS unsigned char* lds, int b, int cidx, int h, int tid, int lane) {
    asm volatile("" : "+v"(tid), "+v"(lane));
    const int dir = tid >> 8, gtid = tid & 255;
    LAS unsigned char* rec = lds + dir * rw::REC_BYTES; LAS unsigned char* scr = lds + RW_SCR0 + dir * rw::SCR_BYTES;
    rw::Consts K; float w0s, a0s, kks, kas, rks; rw::load_consts(P, h, dir, gtid, lane, K, w0s, a0s, kks, kas, rks);
    const int t0 = cidx * 16;
    float* bon = (float*)(P.ws + WS_BONUS) + (size_t)((dir * 2 + b) * 8 + h) * 2048 + (dir ? t0 + 15 : t0);
    __syncthreads();
    rw::prep_chunk(P, rec, scr, MP + b * 2048, 2048, t0, h, dir, K, w0s, a0s, kks, kas, rks, bon, dir ? -1 : 1, gtid, lane);
    const int ci = dir ? 127 - cidx : cidx;
    v4u* dst = (v4u*)(P.ws + WS_REC + ((size_t)((b * 8 + h) * 2 + dir) * 128 + ci) * rw::REC_BYTES);
    for (int i = gtid; i < rw::REC_BYTES / 16; i += 256) dst[i] = *(const LAS v4u*)(rec + i * 16);
}
__device__ __forceinline__ void rw_scan_unit_sample(const Params& P, LAS unsigned char* lds, int b, int h, int tid, int wave, int lane) {
    asm volatile("" : "+v"(tid), "+v"(lane));
    const int dir = tid >> 8, gtid = tid & 255, wq = (tid >> 6) & 3, l15 = lane & 15, g = lane >> 4;
    LAS unsigned char* buf = lds + dir * 2 * rw::REC_BYTES;
    const v4u* src = (const v4u*)(P.ws + WS_REC + (size_t)((b * 8 + h) * 2 + dir) * 128 * rw::REC_BYTES);
    constexpr int NPC = rw::REC_BYTES / 16;
    rw::f32x4 acc[4];
    { const float* s0 = P.in[I_ST] + ((((size_t)b * 2 + dir) * 8 + h) * 64 + 16 * wq + l15) * 64 + 4 * g;
#pragma unroll
      for (int mt = 0; mt < 4; ++mt) acc[mt] = *(const rw::f32x4*)(s0 + 16 * mt); }
    __syncthreads();
    for (int i = gtid; i < NPC; i += 256) *(LAS v4u*)(buf + i * 16) = src[i];
    __syncthreads();
    float* ybase = (float*)(P.ws + (dir ? WS_YB : WS_YF)) + (size_t)(MP + b * 2048) * 512 + h * 64;
    for (int ci = 0; ci < 128; ++ci) {
        v4u st[4];
        const bool more = ci + 1 < 128;
        if (more) { const v4u* s2 = src + (size_t)(ci + 1) * NPC;
#pragma unroll
            for (int q = 0; q < 4; ++q) { const int i = gtid + 256 * q; if (i < NPC) st[q] = s2[i]; } }
        float* yd = ybase + (size_t)(dir ? 2047 - ci * 16 : ci * 16) * 512;
        rw::scan_chunk(buf + (ci & 1) * rw::REC_BYTES, acc, yd, dir ? -512 : 512, wq, lane);
        if (more) { LAS unsigned char* nb = buf + ((ci + 1) & 1) * rw::REC_BYTES;
#pragma unroll
            for (int q = 0; q < 4; ++q) { const int i = gtid + 256 * q; if (i < NPC) *(LAS v4u*)(nb + i * 16) = st[q]; } }
        __syncthreads();
    }
    __threadfence(); __syncthreads();
    const float* bon = (const float*)(P.ws + WS_BONUS) + (size_t)(b * 8 + h) * 2048;
    rw::post_unit(P, MP + b * 2048, 2048, h, bon, bon + (size_t)16 * 2048, wave, lane);
}
__device__ __forceinline__ void rw_unit_prompt(const Params& P, LAS unsigned char* lds, int b, int h, int tid, int wave, int lane) {
    asm volatile("" : "+v"(tid), "+v"(lane));
    const int dir = tid >> 8, gtid = tid & 255, wq = (tid >> 6) & 3, l15 = lane & 15, g = lane >> 4;
    LAS unsigned char* rec = lds + dir * rw::REC_BYTES; LAS unsigned char* scr = lds + RW_SCR0 + dir * rw::SCR_BYTES;
    float* bonl = (float*)((LAS float*)(lds + RW_BON));
    rw::Consts K; float w0s, a0s, kks, kas, rks; rw::load_consts(P, h, dir, gtid, lane, K, w0s, a0s, kks, kas, rks);
    rw::f32x4 acc[4];
#pragma unroll
    for (int mt = 0; mt < 4; ++mt) acc[mt] = (rw::f32x4){0.f, 0.f, 0.f, 0.f};
    float* ybase = (float*)(P.ws + (dir ? WS_YB : WS_YF)) + (size_t)(b * 256) * 512 + h * 64;
    for (int ci = 0; ci < 16; ++ci) {
        const int t0 = dir ? 240 - ci * 16 : ci * 16;
        int gt2 = gtid, ln2 = lane; asm volatile("" : "+v"(gt2), "+v"(ln2));
        __syncthreads();
        rw::prep_chunk(P, rec, scr, b * 256, 256, t0, h, dir, K, w0s, a0s, kks, kas, rks, bonl + dir * 256 + (dir ? t0 + 15 : t0), dir ? -1 : 1, gt2, ln2);
        float* yd = ybase + (size_t)(dir ? t0 + 15 : t0) * 512;
        asm volatile("" : "+v"(ln2));
        rw::scan_chunk(rec, acc, yd, dir ? -512 : 512, wq, ln2);
    }
    { float* so = P.out + OUT_ST + ((((size_t)b * 2 + dir) * 8 + h) * 64 + 16 * wq + l15) * 64 + 4 * g;
#pragma unroll
      for (int mt = 0; mt < 4; ++mt) *(rw::f32x4*)(so + 16 * mt) = acc[mt]; }
    __threadfence(); __syncthreads();
    rw::post_unit(P, b * 256, 256, h, bonl, bonl + 256, wave, lane);
}
constexpr int NPH = 11;
__global__ void __launch_bounds__(NWAVES * 64, 2) mega_fwd(Params P) {
    extern __shared__ __attribute__((aligned(16))) unsigned char lds_raw[];
    LAS unsigned char* lds = (LAS unsigned char*)lds_raw;
    volatile LAS unsigned* MISC = (volatile LAS unsigned*)(lds + MISC_OFF);
    const int tid = threadIdx.x, lane = tid & 63, wave = __builtin_amdgcn_readfirstlane(tid >> 6);
    const int G = gridDim.x; const int bx = blockIdx.x; const int vcu = (G % 8 == 0) ? (bx % 8) * (G / 8) + bx / 8 : bx;
    gu32* ctl = (gu32*)(P.ws + WS_CTL);
    for (int u = tid; u < (LDS_BYTES - LDSCTL_OFF) / 4; u += NWAVES * 64) ((LAS unsigned*)(lds + LDSCTL_OFF))[u] = 0u;
    __syncthreads();
    XcdBarrier bar = xcd_barrier_post((unsigned*)(ctl + CW_BAR), MISC + 8);
    const int lo = P.ph_lo, hi = P.ph_hi;
#define IN(k) (lo <= (k) && (k) < hi)
#define SEAM(k) do { if (IN(k) && IN((k) + 1)) xcd_barrier(bar); } while (0)

    if (IN(0)) { p0_prologue(P, lds, G, vcu, wave, lane, tid); } SEAM(0);
    if (IN(1)) { p1_hprep(P, lds, G, vcu, wave, lane, tid); } SEAM(1);
    if (IN(2)) {
        pg8::Gemm g{(const pg8::bf16_t*)(P.ws + WS_XN), (const pg8::bf16_t*)(P.ws + WS_WT0), M, N0P, D}; pg8::StaticOrder S; S.init(M, N0P, G, bx);
        pg8::EpiIn E{(pg8::bf16_t*)(P.ws + WS_PROJ), N0, N0, 640, (const float*)(P.ws + WS_ROPE), P.out + OUT_AK, P.out + OUT_AV, 512, 640, 640, 768, 128, 128};
        pg8::gemm_phase<pg8::EpiIn, pg8::StaticOrder, true, true>(lds, g, S, E);
    } SEAM(2);
    if (IN(3)) {
        for (int u = bx; u < 384 + 2048; u += G) {
            if (u < 128) attnA_unit(P, lds, true, u >> 6, (u >> 3) & 7, u & 7, tid, wave, lane);
            else if (u < 384) { const int i = u - 128; attnA_unit(P, lds, false, i >> 3, i & 7, 0, tid, wave, lane); }
            else { const int i = u - 384; rw_prep_item_sample(P, lds, i >> 10, (i >> 3) & 127, i & 7, tid, lane); }
            __syncthreads();
        }
    } SEAM(3);
    if (IN(4)) {
        for (int u = bx; u < 272; u += G) {
            if (u < 16) rw_scan_unit_sample(P, lds, u >> 3, u & 7, tid, wave, lane);
            else rw_unit_prompt(P, lds, (u - 16) >> 3, (u - 16) & 7, tid, wave, lane);
            __syncthreads();
        }
    } SEAM(4);
    if (IN(5)) {
        pg8::Gemm g{(const pg8::bf16_t*)(P.ws + WS_MIX), (const pg8::bf16_t*)(P.ws + WS_WO0), M, D, D}; pg8::StaticOrder S; S.init(M, D, G, bx);
        pg8::EpiF32 E{(float*)(P.ws + WS_Y), D};
        pg8::gemm_phase<pg8::EpiF32, pg8::StaticOrder, true, true>(lds, g, S, E);
    } SEAM(5);
    if (IN(6)) { p6_mid(P, lds, G, vcu, wave, lane, tid); } SEAM(6);
    if (IN(7)) {
        pg8::Gemm g{(const pg8::bf16_t*)(P.ws + WS_XN), (const pg8::bf16_t*)(P.ws + WS_WT1), M, N1, D}; pg8::StaticOrder S; S.init(M, N1, G, bx);
        pg8::EpiIn E{(pg8::bf16_t*)(P.ws + WS_PROJ), N1, N1, 2048, (const float*)(P.ws + WS_ROPE), P.out + OUT_CK, P.out + OUT_CV, 1024, 2048, 2048, 3072, 1024, 1024};
        pg8::gemm_phase<pg8::EpiIn, pg8::StaticOrder, true, true>(lds, g, S, E);
    } SEAM(7);
    if (IN(8)) {
        const float d1 = wave_sum(P.in[I_LQ1][lane] * P.in[I_LK1][lane]), d2 = wave_sum(P.in[I_LQ2][lane] * P.in[I_LK2][lane]);
        const float lam = expf(d1) - expf(d2) + 0.35550906759f;
        for (int u = bx; u < 768; u += G) {
            if (u < 256) attnC_unit(P, lds, true, u >> 7, (u >> 4) & 7, u & 15, lam, tid, wave, lane);
            else { const int i = u - 256; attnC_unit(P, lds, false, i >> 4, (i >> 1) & 7, i & 1, lam, tid, wave, lane); }
            __syncthreads();
        }
    } SEAM(8);
    if (IN(9)) {
        pg8::Gemm g{(const pg8::bf16_t*)(P.ws + WS_MIX), (const pg8::bf16_t*)(P.ws + WS_WO1), M, D, D}; pg8::StaticOrder S; S.init(M, D, G, bx);
        pg8::EpiF32 E{(float*)(P.ws + WS_Y), D};
        pg8::gemm_phase<pg8::EpiF32, pg8::StaticOrder, true, true>(lds, g, S, E);
    } SEAM(9);
    if (IN(10)) { p10_final(P, lds, G, vcu, wave, lane, tid); }
#undef IN
#undef SEAM
}

extern "C" void kernel_launch(void* const* d_in, const int* in_sizes, int n_in, void* d_out, int out_size, void* d_ws, size_t ws_size, hipStream_t stream) {
    static int grid = 0;
    if (grid == 0) {
        if (n_in != 32 || out_size != 33554432 || ws_size < WS_END) { fprintf(stderr, "kernel_launch: unexpected shapes (n_in %d out %d ws %zu)\n", n_in, out_size, ws_size); grid = -1; return; }
        int dev = 0, cus = 0, per_cu = 0;
        if (hipGetDevice(&dev) != hipSuccess || hipDeviceGetAttribute(&cus, hipDeviceAttributeMultiprocessorCount, dev) != hipSuccess) { grid = -1; return; }
        if (hipFuncSetAttribute((const void*)mega_fwd, hipFuncAttributeMaxDynamicSharedMemorySize, LDS_BYTES) != hipSuccess) { fprintf(stderr, "kernel_launch: hipFuncSetAttribute failed\n"); grid = -1; return; }
        if (hipOccupancyMaxActiveBlocksPerMultiprocessor(&per_cu, (const void*)mega_fwd, NWAVES * 64, LDS_BYTES) != hipSuccess || per_cu < 1) { fprintf(stderr, "kernel_launch: occupancy query says %d\n", per_cu); per_cu = 1; }
        (void)hipGetLastError();
        grid = cus;
    }
    if (grid < 0) return;
    (void)hipMemsetAsync((char*)d_ws + WS_CTL, 0, CTL_ZERO_BYTES, stream);
    Params a{};
    for (int i = 0; i < 32; ++i) a.in[i] = (const float*)d_in[i];
    a.out = (float*)d_out; a.ws = (unsigned char*)d_ws;
#ifndef MK_PER_PHASE
    a.ph_lo = 0; a.ph_hi = NPH;
    hipLaunchKernelGGL(mega_fwd, dim3(grid), dim3(NWAVES * 64), LDS_BYTES, stream, a);
#else
    for (int p = 0; p < NPH; ++p) { a.ph_lo = p; a.ph_hi = p + 1; hipLaunchKernelGGL(mega_fwd, dim3(grid), dim3(NWAVES * 64), LDS_BYTES, stream, a); }
#endif
    const hipError_t le = hipPeekAtLastError();
    if (le != hipSuccess) fprintf(stderr, "kernel_launch: launch failed: %s\n", hipGetErrorName(le));
}
```

```cpp
#include <hip/hip_runtime.h>
#include <cstdio>
#include <cstdint>
namespace pg8 {
#define PG8_LAS __attribute__((address_space(3)))
typedef unsigned short bf16_t;
typedef short bf16x8 __attribute__((ext_vector_type(8)));
typedef float f32x4 __attribute__((ext_vector_type(4)));
typedef unsigned u32x4 __attribute__((ext_vector_type(4)));
constexpr int BM = 256, BK = 64, HALF = 128, HTB = HALF * BK * 2  , STAGE_BYTES = 8 * HTB, NXCD = 8, WGM = 8;

__host__ __device__ __forceinline__ int lds_byte(int r, int c) { const int st = (r >> 4) * 2 + (c >> 5), rr = r & 15, cc = c & 31, ob = rr * 64 + cc * 2; return st * 1024 + (ob ^ (((ob >> 9) & 1) << 5)); }
__host__ __device__ __forceinline__ void stage_rc(int b, int& R, int& C) { const int st = b / 1024, sb = b % 1024, swz = sb ^ (((sb >> 9) & 1) << 5); R = (st >> 1) * 16 + swz / 64; C = (st & 1) * 32 + (swz % 64) / 2; }
__host__ __device__ __forceinline__ int perm32(int rho) { const int n = rho >> 4, i = rho & 15; return 8 * (i >> 2) + 4 * n + (i & 3); }

struct Unit { int pm, pn; };
struct Gemm { const bf16_t* A; const bf16_t* Bt; int M, N, K; };

struct StaticOrder {
    int nM, nN, nwg, G, c;
    __host__ __device__ void init(int M, int N, int G_, int c_) { nM = M / BM; nN = N / BM; nwg = nM * nN; G = G_; c = c_; }
    __host__ __device__ bool next(int i, Unit& u) const {
        const long L = (long)i * G + c; if (L >= nwg) return false;
        int wgid = (int)L; { const int q = nwg / NXCD, r = nwg % NXCD, xcd = wgid % NXCD, off = wgid / NXCD; wgid = (xcd < r ? xcd * (q + 1) : r * (q + 1) + (xcd - r) * q) + off; }
        const int nig = WGM * nN, gid = wgid / nig, fm = gid * WGM, gsz = (nM - fm) < WGM ? (nM - fm) : WGM;
        u.pm = fm + ((wgid % nig) % gsz); u.pn = (wgid % nig) / gsz; return true;
    }
    __device__ __forceinline__ void a_ready(const Unit&) const {}
    __device__ __forceinline__ void done(const Unit&) const {}
};

__device__ __forceinline__ unsigned cvt_pk_bf16(float lo, float hi) { unsigned r; asm volatile("v_cvt_pk_bf16_f32 %0, %1, %2" : "=v"(r) : "v"(lo), "v"(hi)); return r; }
typedef float f32x2 __attribute__((ext_vector_type(2)));
struct EpiF32 {
    static constexpr bool PERM = false, AFTER_DRAIN = false;
    float* C; int ldc;
    __device__ __forceinline__ void operator()(const f32x4 (&acc)[2][2][4][2], const Unit& u, int wr, int wc, int fr, int fq) const {
        const int row0 = u.pm * BM + wr * 64 + fr, col0 = u.pn * BM + wc * 32 + 4 * fq;
#pragma unroll
        for (int ai = 0; ai < 2; ++ai)
#pragma unroll
            for (int m = 0; m < 4; ++m) { float* rowp = C + (size_t)(row0 + ai * HALF + m * 16) * ldc + col0;
#pragma unroll
                for (int bj = 0; bj < 2; ++bj)
#pragma unroll
                    for (int n = 0; n < 2; ++n) *(f32x4*)(rowp + bj * HALF + n * 16) = acc[ai][bj][m][n]; }
    }
};
struct EpiIn {
    static constexpr bool PERM = true, AFTER_DRAIN = false;
    bf16_t* O; int ldc; int nvalid; int rope_cols; const float* rope;
    float* out_k; float* out_v; int ck0, ck1, cv0, cv1, cpk, cpv;
    __device__ __forceinline__ void operator()(const f32x4 (&acc)[2][2][4][2], const Unit& u, int wr, int wc, int fr, int fq) const {
#pragma unroll
        for (int bj = 0; bj < 2; ++bj) {
            const int colbase = u.pn * BM + bj * HALF;
            if (colbase >= nvalid) continue;
            const int col0 = colbase + wc * 32 + 8 * fq;
            const bool dorope = (u.pm >= 32) && (colbase < rope_cols);
            const bool isk = (u.pm < 32) && (colbase >= ck0) && (colbase < ck1);
            const bool isv = (u.pm < 32) && (colbase >= cv0) && (colbase < cv1);
#pragma unroll
            for (int ai = 0; ai < 2; ++ai)
#pragma unroll
                for (int m = 0; m < 4; ++m) {
                    const int row = u.pm * BM + ai * HALF + wr * 64 + m * 16 + fr;
                    f32x4 v0 = acc[ai][bj][m][0], v1 = acc[ai][bj][m][1];
                    if (dorope) {
                        const int t = (row - 8192) & 2047; const int pos = (wc & 1) ? (t & 63) : (t >> 6);
                        const float* cs = rope + (pos * 16 + 8 * (fq & 1)) * 2;
                        const float sg = (fq < 2) ? -1.f : 1.f;
                        f32x4 p0, p1;
#pragma unroll
                        for (int i = 0; i < 4; ++i) { p0[i] = __shfl_xor(v0[i], 32); p1[i] = __shfl_xor(v1[i], 32); }
                        const f32x4 c0 = *(const f32x4*)(cs), c1 = *(const f32x4*)(cs + 4), c2 = *(const f32x4*)(cs + 8), c3 = *(const f32x4*)(cs + 12);
                        v0[0] = v0[0] * c0[0] + sg * p0[0] * c0[1]; v0[1] = v0[1] * c0[2] + sg * p0[1] * c0[3];
                        v0[2] = v0[2] * c1[0] + sg * p0[2] * c1[1]; v0[3] = v0[3] * c1[2] + sg * p0[3] * c1[3];
                        v1[0] = v1[0] * c2[0] + sg * p1[0] * c2[1]; v1[1] = v1[1] * c2[2] + sg * p1[1] * c2[3];
                        v1[2] = v1[2] * c3[0] + sg * p1[2] * c3[1]; v1[3] = v1[3] * c3[2] + sg * p1[3] * c3[3];
                    }
                    u32x4 w; w.x = cvt_pk_bf16(v0[0], v0[1]); w.y = cvt_pk_bf16(v0[2], v0[3]); w.z = cvt_pk_bf16(v1[0], v1[1]); w.w = cvt_pk_bf16(v1[2], v1[3]);
                    *(u32x4*)(O + (size_t)row * ldc + col0) = w;
                    if (isk) { float* p = out_k + (size_t)row * cpk + (col0 - ck0); *(f32x4*)p = v0; *(f32x4*)(p + 4) = v1; }
                    if (isv) { float* p = out_v + (size_t)row * cpv + (col0 - cv0); *(f32x4*)p = v0; *(f32x4*)(p + 4) = v1; }
                }
        }
    }
};
template <class Epi, class Sched, bool ALIGN_EPI = false, bool SP2 = false>
__device__ __forceinline__ void gemm_phase(PG8_LAS unsigned char* lds, const Gemm g, const Sched& S, const Epi& E) {
    const int tid = threadIdx.x, wid = __builtin_amdgcn_readfirstlane(tid >> 6), lane = tid & 63, wr = wid >> 2, wc = wid & 3, fr = lane & 15, fq = lane >> 4;
    const int K = g.K, nt = K / BK;
    unsigned voffA[2], voffB[2];
#pragma unroll
    for (int i = 0; i < 2; ++i) { int R, C; stage_rc(tid * 16 + i * 8192, R, C); const int Rb = Epi::PERM ? ((R & ~31) + perm32(R & 31)) : R;
        voffA[i] = (unsigned)(R * K + C) * 2u; voffB[i] = (unsigned)(Rb * K + C) * 2u; }
    const size_t kstep = (size_t)(BK * 2);
    const size_t hstep = (size_t)HALF * K * 2;
    const size_t tstep = 2 * hstep;
    const unsigned ldsw = (unsigned)wid * 1024u;
    const int aoff = lds_byte(wr * 64 + fr, fq * 8), boff = lds_byte(wc * 32 + fr, fq * 8);
#define PG8_SA(b, h) (((b) * 2 + (h)) * HTB)
#define PG8_SB(b, h) ((4 + (b) * 2 + (h)) * HTB)
#define PG8_STAGE(bufoff, gbase, voff) do { _Pragma("unroll") for (int _i = 0; _i < 2; ++_i) \
        __builtin_amdgcn_global_load_lds((const unsigned*)((const char*)(gbase) + (voff)[_i]), (PG8_LAS unsigned*)(lds + (bufoff) + ldsw + _i * 8192), 16, 0, 0); } while (0)
#define PG8_LDA(dst, b, h) do { _Pragma("unroll") for (int m = 0; m < 4; ++m) _Pragma("unroll") for (int k = 0; k < 2; ++k) dst[m][k] = *(const PG8_LAS bf16x8*)(lds + PG8_SA(b, h) + aoff + m * 2048 + k * 1024); } while (0)
#define PG8_LDB(dst, b, h) do { _Pragma("unroll") for (int n = 0; n < 2; ++n) _Pragma("unroll") for (int k = 0; k < 2; ++k) dst[n][k] = *(const PG8_LAS bf16x8*)(lds + PG8_SB(b, h) + boff + n * 2048 + k * 1024); } while (0)
#define PG8_MMA(ai, bj, At, Bt) do { __builtin_amdgcn_s_setprio(1); _Pragma("unroll") for (int m = 0; m < 4; ++m) _Pragma("unroll") for (int n = 0; n < 2; ++n) _Pragma("unroll") for (int k = 0; k < 2; ++k) \
        acc[ai][bj][m][n] = __builtin_amdgcn_mfma_f32_16x16x32_bf16(Bt[n][k], At[m][k], acc[ai][bj][m][n], 0, 0, 0); __builtin_amdgcn_s_setprio(0); } while (0)
#define PG8_WAIT_V(n) asm volatile("s_waitcnt vmcnt(" #n ")" ::: "memory")
#define PG8_WAIT_L(n) asm volatile("s_waitcnt lgkmcnt(" #n ")" ::: "memory")
#define PG8_BAR __builtin_amdgcn_s_barrier()
#define PG8_SCHED __builtin_amdgcn_sched_barrier(0)
    Unit cur, nxt; int ui = 0;
    if (!S.next(0, cur)) return;
    f32x4 acc[2][2][4][2];
#pragma unroll
    for (int a = 0; a < 2; ++a)
#pragma unroll
        for (int b = 0; b < 2; ++b)
#pragma unroll
            for (int m = 0; m < 4; ++m)
#pragma unroll
                for (int n = 0; n < 2; ++n) acc[a][b][m][n] = (f32x4){0.f, 0.f, 0.f, 0.f};
    bf16x8 At[4][2], B0[2][2], B1[2][2];
    const char* cA = (const char*)g.A + (size_t)cur.pm * tstep; const char* cB = (const char*)g.Bt + (size_t)cur.pn * tstep;
    S.a_ready(cur);
    if constexpr (SP2) {
        PG8_STAGE(PG8_SB(0, 0), cB, voffB); PG8_STAGE(PG8_SB(0, 1), cB + hstep, voffB); PG8_STAGE(PG8_SA(0, 0), cA, voffA); PG8_STAGE(PG8_SA(0, 1), cA + hstep, voffA);
        if (wr == 1) PG8_BAR;
        PG8_WAIT_V(2); PG8_BAR;
        PG8_STAGE(PG8_SB(1, 0), cB + kstep, voffB); PG8_STAGE(PG8_SA(1, 0), cA + kstep, voffA); PG8_STAGE(PG8_SB(1, 1), cB + hstep + kstep, voffB);
        PG8_WAIT_V(6); PG8_BAR;
    } else {
        PG8_STAGE(PG8_SB(0, 0), cB, voffB); PG8_STAGE(PG8_SA(0, 0), cA, voffA); PG8_STAGE(PG8_SB(0, 1), cB + hstep, voffB); PG8_STAGE(PG8_SA(0, 1), cA + hstep, voffA);
        if (wr == 1) PG8_BAR;
        PG8_WAIT_V(4); PG8_BAR;
        PG8_STAGE(PG8_SB(1, 0), cB + kstep, voffB); PG8_STAGE(PG8_SA(1, 0), cA + kstep, voffA); PG8_STAGE(PG8_SB(1, 1), cB + hstep + kstep, voffB);
        PG8_WAIT_V(6); PG8_BAR;
    }
    for (;;) {
        const bool has_next = S.next(ui + 1, nxt);
        const char* nA = has_next ? (const char*)g.A + (size_t)nxt.pm * tstep : cA; const char* nB = has_next ? (const char*)g.Bt + (size_t)nxt.pn * tstep : cB;
        for (int t = 0; t < nt; t += 2) {
            const bool last = (t == nt - 2);
            const char* a1 = cA + (size_t)(t + 1) * kstep;
            const char* a2 = last ? nA : cA + (size_t)(t + 2) * kstep; const char* b2 = last ? nB : cB + (size_t)(t + 2) * kstep;
            const char* a3 = a2 + kstep; const char* b3 = b2 + kstep;
            if (last && has_next) S.a_ready(nxt);
            if constexpr (SP2) {
            PG8_LDB(B0, 0, 0); PG8_LDB(B1, 0, 1); PG8_SCHED; PG8_LDA(At, 0, 0); PG8_STAGE(PG8_SA(1, 1), a1 + hstep, voffA);
            PG8_WAIT_V(8); PG8_WAIT_L(0); PG8_BAR; PG8_MMA(0, 0, At, B0); PG8_MMA(0, 1, At, B1); PG8_BAR; PG8_SCHED;
            PG8_LDA(At, 0, 1); PG8_STAGE(PG8_SB(0, 0), b2, voffB); PG8_STAGE(PG8_SB(0, 1), b2 + hstep, voffB); PG8_STAGE(PG8_SA(0, 0), a2, voffA);
            PG8_WAIT_V(8); PG8_WAIT_L(0); PG8_BAR; PG8_MMA(1, 0, At, B0); PG8_MMA(1, 1, At, B1); PG8_BAR; PG8_SCHED;
            PG8_LDB(B0, 1, 0); PG8_LDB(B1, 1, 1); PG8_SCHED; PG8_LDA(At, 1, 0); PG8_STAGE(PG8_SA(0, 1), a2 + hstep, voffA);
            PG8_WAIT_V(8); PG8_WAIT_L(0); PG8_BAR; PG8_MMA(0, 0, At, B0); PG8_MMA(0, 1, At, B1); PG8_BAR; PG8_SCHED;
            PG8_LDA(At, 1, 1); PG8_STAGE(PG8_SB(1, 0), b3, voffB); PG8_STAGE(PG8_SB(1, 1), b3 + hstep, voffB); PG8_STAGE(PG8_SA(1, 0), a3, voffA);
            PG8_WAIT_V(8); PG8_WAIT_L(0); PG8_BAR; PG8_MMA(1, 0, At, B0); PG8_MMA(1, 1, At, B1); PG8_BAR; PG8_SCHED;
            } else {
            PG8_LDB(B0, 0, 0); PG8_SCHED; PG8_LDA(At, 0, 0); PG8_STAGE(PG8_SA(1, 1), a1 + hstep, voffA);
            PG8_WAIT_L(8); PG8_BAR; PG8_WAIT_L(0); PG8_MMA(0, 0, At, B0); PG8_BAR; PG8_SCHED;
            PG8_LDB(B1, 0, 1); PG8_STAGE(PG8_SB(0, 0), b2, voffB);
            PG8_BAR; PG8_WAIT_L(0); PG8_MMA(0, 1, At, B1); PG8_BAR;
            PG8_LDA(At, 0, 1); PG8_STAGE(PG8_SA(0, 0), a2, voffA);
            PG8_BAR; PG8_WAIT_L(0); PG8_MMA(1, 0, At, B0); PG8_BAR; PG8_SCHED;
            PG8_STAGE(PG8_SB(0, 1), b2 + hstep, voffB);
            PG8_WAIT_V(6); PG8_BAR; PG8_MMA(1, 1, At, B1); PG8_BAR;
            PG8_LDB(B0, 1, 0); PG8_SCHED; PG8_LDA(At, 1, 0); PG8_STAGE(PG8_SA(0, 1), a2 + hstep, voffA);
            PG8_WAIT_L(8); PG8_BAR; PG8_WAIT_L(0); PG8_MMA(0, 0, At, B0); PG8_BAR; PG8_SCHED;
            PG8_LDB(B1, 1, 1); PG8_STAGE(PG8_SB(1, 0), b3, voffB);
            PG8_BAR; PG8_WAIT_L(0); PG8_MMA(0, 1, At, B1); PG8_BAR;
            PG8_LDA(At, 1, 1); PG8_STAGE(PG8_SA(1, 0), a3, voffA);
            PG8_BAR; PG8_WAIT_L(0); PG8_MMA(1, 0, At, B0); PG8_BAR; PG8_SCHED;
            PG8_STAGE(PG8_SB(1, 1), b3 + hstep, voffB);
            PG8_WAIT_V(6); PG8_BAR; PG8_MMA(1, 1, At, B1); PG8_BAR;
            }
        }
        if constexpr (ALIGN_EPI) { if (wr == 0) PG8_BAR; }
        if constexpr (!Epi::AFTER_DRAIN) { E(acc, cur, wr, wc, fr, fq); S.done(cur); }
        if (!has_next) break;
#pragma unroll
        for (int a = 0; a < 2; ++a)
#pragma unroll
            for (int b = 0; b < 2; ++b)
#pragma unroll
                for (int m = 0; m < 4; ++m)
#pragma unroll
                    for (int n = 0; n < 2; ++n) acc[a][b][m][n] = (f32x4){0.f, 0.f, 0.f, 0.f};
        cur = nxt; cA = nA; cB = nB; ++ui;
        if constexpr (ALIGN_EPI) { if (wr == 1) PG8_BAR; }
    }
    PG8_WAIT_V(0);
    if constexpr (!ALIGN_EPI) { if (wr == 0) PG8_BAR; }
    PG8_BAR;
    if constexpr (Epi::AFTER_DRAIN) { E.fused(acc, cur, wr, wc, fr, fq, lds, wid, lane); S.done(cur); }
#undef PG8_SA
#undef PG8_SB
#undef PG8_STAGE
#undef PG8_LDA
#undef PG8_LDB
#undef PG8_MMA
#undef PG8_WAIT_V
#undef PG8_WAIT_L
#undef PG8_BAR
#undef PG8_SCHED
}
}
#define GAS __attribute__((address_space(1)))
#define LAS __attribute__((address_space(3)))
typedef unsigned short bf16;
typedef unsigned v4u __attribute__((ext_vector_type(4)));
typedef float f32x4 __attribute__((ext_vector_type(4)));
typedef short bf16x8 __attribute__((ext_vector_type(8)));
typedef GAS unsigned gu32;
typedef GAS unsigned long long gu64;
#define RLX_AGENT __ATOMIC_RELAXED, __HIP_MEMORY_SCOPE_AGENT
#define LDS_WAIT() asm volatile("s_waitcnt lgkmcnt(0)" ::: "memory")
#define VM_WAIT() asm volatile("s_waitcnt vmcnt(0)" ::: "memory")
__device__ __forceinline__ unsigned long long rt() { return __builtin_amdgcn_s_memrealtime(); }
__device__ __forceinline__ unsigned f2bf(float f) { unsigned u = __builtin_bit_cast(unsigned, f); return (u + 0x7fffu + ((u >> 16) & 1u)) >> 16; }
__device__ __forceinline__ unsigned pk2(float lo, float hi) { return f2bf(lo) | (f2bf(hi) << 16); }

#define XB_TMO      128
#define XB_XCNT(j)  (256  + 64 * (j))
#define XB_XSUB(j)  (1280 + 64 * (j))
#define XB_XGEN(j)  (2304 + 64 * (j))
#define XB_TOP      3328
#define XB_TOPGEN   3392
#define XCD_BAR_WORDS 3456
#define XB_SPIN_CAP (1u << 18)

__device__ __forceinline__ unsigned xb_ld(unsigned* p)              { return __hip_atomic_load(p, __ATOMIC_RELAXED, __HIP_MEMORY_SCOPE_AGENT); }
__device__ __forceinline__ unsigned xb_add(unsigned* p, unsigned v) { return __hip_atomic_fetch_add(p, v, __ATOMIC_RELAXED, __HIP_MEMORY_SCOPE_AGENT); }
__device__ __forceinline__ unsigned xb_xcc_id() { return (unsigned)__builtin_amdgcn_s_getreg((3 << 11) | 20) & 0xFu; }
#define XB_SPIN(cond, bar) do { unsigned _sp = 0; while (cond) { __builtin_amdgcn_s_sleep(1); \
    if ((++_sp & 255u) == 0u) { if (xb_ld(&(bar)[XB_TMO])) break; if (_sp > XB_SPIN_CAP) { atomicAdd(&(bar)[XB_TMO], 1u); break; } } } } while (0)

struct XcdBarrier {
    unsigned* bar; unsigned x;
    volatile LAS unsigned* st;
};

__device__ __forceinline__ XcdBarrier xcd_barrier_post(unsigned* bar, volatile LAS unsigned* st) {
    XcdBarrier b; b.bar = bar; b.x = xb_xcc_id(); b.st = st;
    if (threadIdx.x == 0) (void)xb_add(&bar[XB_XCNT(b.x)], 1u);
    return b;
}
__device__ __forceinline__ void xcd_barrier_complete(unsigned* bar, unsigned x, unsigned& nloc, unsigned& nx) {
    const unsigned G = gridDim.x * gridDim.y * gridDim.z;
    unsigned sum, cnt, mine, sp = 0u;
    for (;;) {
        sum = 0u; cnt = 0u; mine = 0u;
#pragma unroll
        for (unsigned j = 0; j < 16; ++j) { const unsigned c = xb_ld(&bar[XB_XCNT(j)]); sum += c; cnt += (c > 0u) ? 1u : 0u; mine = (j == x) ? c : mine; }
        if (sum == G) break;
        __builtin_amdgcn_s_sleep(1);
        if ((++sp & 255u) == 0u) { if (xb_ld(&bar[XB_TMO])) break; if (sp > XB_SPIN_CAP) { atomicAdd(&bar[XB_TMO], 1u); break; } }
    }
    nloc = mine > 0u ? mine : 1u; nx = cnt > 0u ? cnt : 1u;
}

__device__ __forceinline__ void xcd_barrier(const XcdBarrier& b) {
    asm volatile("s_waitcnt vmcnt(0)" ::: "memory");
    __syncthreads();
    if (threadIdx.x == 0) {
        unsigned* bar = b.bar;
        __builtin_amdgcn_s_waitcnt(0);
        unsigned nloc = b.st[0], nx = b.st[1];
        if (nloc == 0u) { xcd_barrier_complete(bar, b.x, nloc, nx); b.st[0] = nloc; b.st[1] = nx; }
        const unsigned old = xb_add(&bar[XB_XSUB(b.x)], 1u);
        const unsigned gen = old / nloc;
        if (old + 1u == (gen + 1u) * nloc) {
            __builtin_amdgcn_fence(__ATOMIC_RELEASE, "agent");
            asm volatile("s_waitcnt vmcnt(0)" ::: "memory");
            const unsigned og = xb_add(&bar[XB_TOP], 1u);
            const unsigned tg = og / nx;
            if (og + 1u == (tg + 1u) * nx) xb_add(&bar[XB_TOPGEN], 1u);
            else XB_SPIN(xb_ld(&bar[XB_TOPGEN]) == tg, bar);
            __builtin_amdgcn_fence(__ATOMIC_ACQUIRE, "agent");
            xb_add(&bar[XB_XGEN(b.x)], 1u);
            asm volatile("s_waitcnt vmcnt(0)" ::: "memory");
        } else {
            XB_SPIN(xb_ld(&bar[XB_XGEN(b.x)]) == gen, bar);
            __builtin_amdgcn_fence(__ATOMIC_ACQUIRE, "agent");
            asm volatile("s_waitcnt vmcnt(0)" ::: "memory");
        }
    }
    __syncthreads();
}
constexpr int NWAVES = 8;
constexpr int D = 1024, MP = 8192, MS = 4096, M = MP + MS;
constexpr int N0 = 3456, N0P = 3584, N1 = 4096;
constexpr float NORM_EPS = 1e-6f;
constexpr size_t OUT_Y = 0, OUT_AK = 12582912, OUT_AV = 13631488, OUT_ST = 14680064, OUT_CK = 16777216, OUT_CV = 25165824;
constexpr size_t MiB = 1u << 20;
constexpr size_t WS_CTL = 0, CTL_ZERO_BYTES = 64 * 1024;
constexpr size_t WS_WT0 = 2 * MiB, WS_WO0 = 9 * MiB, WS_WT1 = 11 * MiB, WS_WO1 = 19 * MiB;
constexpr size_t WS_MODP = 21 * MiB, WS_ROPE = 22 * MiB, WS_LORA = 22 * MiB + 65536;
constexpr size_t WS_CAK = 23 * MiB, WS_CAV = WS_CAK + 131072, WS_CCK = WS_CAV + 131072, WS_CCV = WS_CCK + MiB;
constexpr size_t WS_BONUS = 26 * MiB, WS_XN = 27 * MiB, WS_MIX = 51 * MiB, WS_PROJ = 75 * MiB, WS_Y = 171 * MiB, WS_REC = 171 * MiB, WS_YF = 27 * MiB, WS_YB = 225 * MiB, WS_END = 249 * MiB;
constexpr int CW_BAR = 4096;
constexpr int RING_BYTES = 131072, LDSCTL_OFF = RING_BYTES, MISC_OFF = LDSCTL_OFF + 320, LDS_BYTES = 147456;

struct Params { const float* in[32]; float* out; unsigned char* ws; int ph_lo, ph_hi; };
enum { I_XP = 0, I_XS, I_CAK, I_CAV, I_ST, I_CCK, I_CCV, I_C, I_CCTX, I_ADAW, I_ADAB, I_NPRE, I_NPOST, I_WOUT, I_EWIN, I_SINK, I_MU, I_W0, I_W2, I_A0, I_A2, I_KK, I_KA, I_RK,
       I_LNW, I_LNB, I_OWIN, I_LQ1, I_LK1, I_LQ2, I_LK2, I_SUBLN };

__device__ __forceinline__ float wave_sum(float v) {
#pragma unroll
    for (int o = 1; o < 64; o <<= 1) v += __shfl_xor(v, o);
    return v;
}
__device__ __forceinline__ float bf2f(bf16 v) { return __builtin_bit_cast(float, (unsigned)v << 16); }
__device__ __forceinline__ float silu_f(float x) { return x * __builtin_amdgcn_rcpf(1.f + __expf(-x)); }
__device__ __forceinline__ const float* xrow(const Params& P, int r) { return r < MP ? P.in[I_XP] + (size_t)r * D : P.in[I_XS] + (size_t)(r - MP) * D; }
__device__ __forceinline__ int modidx(int r) { return r < MP ? 0 : 1 + ((r - MP) >> 11); }

__device__ __forceinline__ void p0_transpose_item(const float* W, int K, int N, bf16* WT, LAS float* scr, int item, int lane) {
    const int nblk = N / 32, kb = item / nblk, nb = item % nblk, k0 = 64 * kb, n0 = 32 * nb;
#pragma unroll 8
    for (int i = 0; i < 32; ++i) { const int kk = 2 * i + (lane >> 5); scr[kk * 33 + (lane & 31)] = W[(size_t)(k0 + kk) * N + n0 + (lane & 31)]; }
    LDS_WAIT(); asm volatile("" ::: "memory");
    const int c = lane & 7;
#pragma unroll
    for (int j = 0; j < 4; ++j) { const int n = (lane >> 3) + 8 * j; const LAS float* s = scr + (8 * c) * 33 + n;
        v4u o; o.x = pk2(s[0 * 33], s[1 * 33]); o.y = pk2(s[2 * 33], s[3 * 33]); o.z = pk2(s[4 * 33], s[5 * 33]); o.w = pk2(s[6 * 33], s[7 * 33]);
        *(GAS v4u*)(WT + (size_t)(n0 + n) * K + k0 + 8 * c) = o; }
    LDS_WAIT(); asm volatile("" ::: "memory");
}
__device__ __forceinline__ float mod_val(const Params& P, int l, int j, int n) {
    const float* mp = (const float*)(P.ws + WS_MODP);
    float s = P.in[I_ADAB][l * 3072 + n];
#pragma unroll
    for (int kc = 0; kc < 8; ++kc) s += mp[((l * 8 + kc) * 3 + j) * 3072 + n];
    return s;
}

__device__ __forceinline__ void p0_prologue(const Params& P, LAS unsigned char* lds, int G, int vcu, int wave, int lane, int tid) {
    LAS float* scr = (LAS float*)(lds + wave * 16384);
    const int gw = vcu * NWAVES + wave, NGW = G * NWAVES;
    constexpr int I_T0 = 16 * (N0 / 32), I_TO = 16 * 32, I_T1 = 16 * (N1 / 32), I_MOD = 2 * 8 * 48;
    constexpr int NITEMS = I_T0 + 2 * I_TO + I_T1 + I_MOD;
    for (int it = gw; it < NITEMS; it += NGW) {
        int r = it;
        if (r < I_MOD) {
            const int l = r / 384, rem = r % 384, kc = rem / 48, nb = rem % 48, n = nb * 64 + lane, k0 = kc * 128;
            const float* W = P.in[I_ADAW] + ((size_t)l * 1024 + k0) * 3072 + n;
            const float* c0p = P.in[I_CCTX] + k0; const float* c1p = P.in[I_C] + k0; const float* c2p = P.in[I_C] + 1024 + k0;
            float a0 = 0.f, a1 = 0.f, a2 = 0.f;
#pragma unroll 8
            for (int kk = 0; kk < 128; ++kk) { const float w = W[(size_t)kk * 3072];
                a0 += silu_f(c0p[kk]) * w; a1 += silu_f(c1p[kk]) * w; a2 += silu_f(c2p[kk]) * w; }
            float* mp = (float*)(P.ws + WS_MODP) + (size_t)((l * 8 + kc) * 3) * 3072 + n;
            mp[0] = a0; mp[3072] = a1; mp[6144] = a2;
            continue; }
        r -= I_MOD;
        if (r < I_T0) { p0_transpose_item(P.in[I_EWIN], D, N0, (bf16*)(P.ws + WS_WT0), scr, r, lane); continue; } r -= I_T0;
        if (r < I_TO) { p0_transpose_item(P.in[I_WOUT], D, D, (bf16*)(P.ws + WS_WO0), scr, r, lane); continue; } r -= I_TO;
        if (r < I_TO) { p0_transpose_item(P.in[I_WOUT] + (size_t)D * D, D, D, (bf16*)(P.ws + WS_WO1), scr, r, lane); continue; } r -= I_TO;
        p0_transpose_item(P.in[I_OWIN], D, N1, (bf16*)(P.ws + WS_WT1), scr, r, lane);
    }
    const int gt = vcu * 512 + tid, NT = G * 512;
    { unsigned* z = (unsigned*)(P.ws + WS_WT0 + (size_t)N0 * D * 2); for (int i = gt; i < 128 * D / 2; i += NT) z[i] = 0u; }
    { const float* s0 = P.in[I_CAK]; const float* s1 = P.in[I_CAV]; const float* s2 = P.in[I_CCK]; const float* s3 = P.in[I_CCV];
      unsigned* d0 = (unsigned*)(P.ws + WS_CAK); unsigned* d1 = (unsigned*)(P.ws + WS_CAV); unsigned* d2 = (unsigned*)(P.ws + WS_CCK); unsigned* d3 = (unsigned*)(P.ws + WS_CCV);
      for (int i = gt; i < 32768; i += NT) { d0[i] = pk2(s0[2 * i], s0[2 * i + 1]); d1[i] = pk2(s1[2 * i], s1[2 * i + 1]); }
      for (int i = gt; i < 262144; i += NT) { d2[i] = pk2(s2[2 * i], s2[2 * i + 1]); d3[i] = pk2(s3[2 * i], s3[2 * i + 1]); } }
    { unsigned short* wt = (unsigned short*)(P.ws + WS_LORA); const float* w2 = P.in[I_W2]; const float* a2 = P.in[I_A2];
      for (int i = gt; i < 65536; i += NT) { const int l = i & 63, cc = (i >> 6) & 63, hh = (i >> 12) & 7, z = i >> 15; const size_t si = (size_t)(z * 64 + l) * 512 + hh * 64 + cc;
        wt[i] = (unsigned short)f2bf(w2[si]); wt[65536 + i] = (unsigned short)f2bf(a2[si]); } }
    { float* rt_ = (float*)(P.ws + WS_ROPE); for (int i = gt; i < 1024; i += NT) { const int pos = i >> 4, f = i & 15;
        const float inv = 1.0f / powf(10000.0f, (float)f / 16.0f); const float ang = (float)pos * inv; float sn, cs; sincosf(ang, &sn, &cs); rt_[2 * i] = cs; rt_[2 * i + 1] = sn; } }
}

__device__ __forceinline__ void p1_hprep(const Params& P, LAS unsigned char* lds, int G, int vcu, int wave, int lane, int tid) {
    LAS float* gs = (LAS float*)lds; LAS float* sh = gs + 3 * 1024;
    for (int i = tid; i < 3 * 1024; i += 512) { const int j = i >> 10, k = i & 1023;
        gs[i] = P.in[I_NPRE][k] * (1.f + mod_val(P, 0, j, 1024 + k)); sh[i] = mod_val(P, 0, j, k); }
    __syncthreads();
    const int gw = vcu * NWAVES + wave, NGW = G * NWAVES;
    bf16* XN = (bf16*)(P.ws + WS_XN);
    for (int r = gw; r < M; r += NGW) {
        const f32x4* xr = (const f32x4*)xrow(P, r) + lane; const int j = modidx(r);
        f32x4 v[4]; float s = 0.f;
#pragma unroll
        for (int q = 0; q < 4; ++q) { v[q] = xr[64 * q]; s += (v[q].x * v[q].x + v[q].y * v[q].y) + (v[q].z * v[q].z + v[q].w * v[q].w); }
        const float rinv = 1.f / sqrtf(wave_sum(s) * (1.f / D) + NORM_EPS);
        unsigned long long* o8 = (unsigned long long*)(XN + (size_t)r * D) + lane;
#pragma unroll
        for (int q = 0; q < 4; ++q) { const int k = 256 * q + 4 * lane; const LAS float* g = gs + j * 1024 + k; const LAS float* b = sh + j * 1024 + k;
            const float o0 = v[q].x * rinv * g[0] + b[0], o1 = v[q].y * rinv * g[1] + b[1], o2 = v[q].z * rinv * g[2] + b[2], o3 = v[q].w * rinv * g[3] + b[3];
            o8[64 * q] = (unsigned long long)pk2(o0, o1) | ((unsigned long long)pk2(o2, o3) << 32); }
    }
    __syncthreads();
}
namespace att {
using bf16x8 = __attribute__((ext_vector_type(8))) short;
using s16x4  = __attribute__((ext_vector_type(4))) short;
using f32x16 = __attribute__((ext_vector_type(16))) float;
using u32x4  = __attribute__((ext_vector_type(4))) unsigned;
constexpr float SCALE = 0.125f, CSC = 0.125f * 1.4426950408889634f, THR = 8.f;
#define ATT_SBAR() __builtin_amdgcn_sched_barrier(0)
__device__ __forceinline__ int crow(int r, int hi) { return (r & 3) + 8 * (r >> 2) + 4 * hi; }
__device__ __forceinline__ unsigned cvtpk(float lo, float hi) { unsigned r; asm volatile("v_cvt_pk_bf16_f32 %0, %1, %2" : "=v"(r) : "v"(lo), "v"(hi)); return r; }
__device__ __forceinline__ void partialSM(f32x16& p0, f32x16& p1, float& m_reg, float& alpha) {
  float pmax = p0[0];
#pragma unroll
  for (int r = 1; r < 16; ++r) pmax = fmaxf(pmax, p0[r]);
#pragma unroll
  for (int r = 0; r < 16; ++r) pmax = fmaxf(pmax, p1[r]);
  { auto rr = __builtin_amdgcn_permlane32_swap(__float_as_uint(pmax), __float_as_uint(pmax), false, false);
    pmax = fmaxf(__uint_as_float(rr[0]), __uint_as_float(rr[1])); }
  float mn;
  if (__builtin_expect(__all(pmax - m_reg <= THR / SCALE), 1)) { mn = m_reg; alpha = 1.f; }
  else { mn = fmaxf(m_reg, pmax); alpha = __builtin_amdgcn_exp2f((m_reg - mn) * CSC); m_reg = mn; }
  const float mnC = -mn * CSC;
#pragma unroll
  for (int r = 0; r < 16; ++r) p0[r] = fmaf(p0[r], CSC, mnC);
#pragma unroll
  for (int r = 0; r < 16; ++r) p1[r] = fmaf(p1[r], CSC, mnC);
#pragma unroll
  for (int r = 0; r < 16; ++r) p0[r] = __builtin_amdgcn_exp2f(p0[r]);
}
__device__ __forceinline__ void finishSM(f32x16& p0, f32x16& p1, float alpha, float& l_reg, bf16x8& pa0, bf16x8& pa1, bf16x8& pa2, bf16x8& pa3) {
#pragma unroll
  for (int r = 0; r < 16; ++r) p1[r] = __builtin_amdgcn_exp2f(p1[r]);
  float ps = 0;
#pragma unroll
  for (int r = 0; r < 16; ++r) ps += p0[r];
#pragma unroll
  for (int r = 0; r < 16; ++r) ps += p1[r];
  { auto rr = __builtin_amdgcn_permlane32_swap(__float_as_uint(ps), __float_as_uint(ps), false, false);
    ps = __uint_as_float(rr[0]) + __uint_as_float(rr[1]); }
  l_reg = l_reg * alpha + ps;
#define PK4(P, BASE, OUT) do { unsigned a0 = cvtpk(P[BASE + 0], P[BASE + 1]), a1 = cvtpk(P[BASE + 2], P[BASE + 3]);   \
    unsigned b0 = cvtpk(P[BASE + 4], P[BASE + 5]), b1 = cvtpk(P[BASE + 6], P[BASE + 7]);                              \
    auto r0 = __builtin_amdgcn_permlane32_swap(a0, b0, false, false); auto r1 = __builtin_amdgcn_permlane32_swap(a1, b1, false, false); \
    u32x4 w = {r0[0], r1[0], r0[1], r1[1]}; OUT = *reinterpret_cast<bf16x8*>(&w); } while (0)
  PK4(p0, 0, pa0); PK4(p0, 8, pa1); PK4(p1, 0, pa2); PK4(p1, 8, pa3);
#undef PK4
}
template <int KW> __device__ __forceinline__ int kswz(int row, int colB) { return row * (KW * 2) + (colB ^ ((row & 7) << 4)); }
template <int KW> __device__ __forceinline__ void qkt(f32x16& p0, f32x16& p1, const LAS unsigned char* Ks, int kcolB, const bf16x8* qr, int r32, int hi) {
  p0 = f32x16{}; p1 = f32x16{};
#pragma unroll
  for (int d0 = 0; d0 < 4; ++d0) { const int cb = kcolB + (d0 * 16 + hi * 8) * 2;
    const bf16x8 b0 = *(const LAS bf16x8*)(Ks + kswz<KW>(r32, cb));
    const bf16x8 b1 = *(const LAS bf16x8*)(Ks + kswz<KW>(32 + r32, cb));
    p0 = __builtin_amdgcn_mfma_f32_32x32x16_bf16(b0, qr[d0], p0, 0, 0, 0);
    p1 = __builtin_amdgcn_mfma_f32_32x32x16_bf16(b1, qr[d0], p1, 0, 0, 0); }
}
template <int NCB> __device__ __forceinline__ int v_st(int k, int c) { const int kk = (k & ~0xC) | ((k & 4) << 1) | ((k & 8) >> 1); return ((kk >> 3) * NCB + (c >> 5)) * 512 + ((kk & 7) * 32 + (c & 31)) * 2; }
__device__ __forceinline__ int v_rd_base(int lane) { return ((lane & 3) << 3) | (((lane >> 2) & 3) << 6) | (((lane >> 4) & 1) << 5) | (((lane >> 5) & 1) << 8); }
template <int NCB> constexpr int v_rd_off(int d0, int ks, int half) { return d0 * 512 + ks * (2 * NCB * 512) + half * (NCB * 512); }
template <int OFF> __device__ __forceinline__ s16x4 tr_read(int vb) { s16x4 r; asm volatile("ds_read_b64_tr_b16 %0, %1 offset:%2" : "=&v"(r) : "v"(vb), "i"(OFF) : "memory"); return r; }
template <int NCB, int D0> __device__ __forceinline__ void pv_one(f32x16& od, int vb, bf16x8 pa0, bf16x8 pa1, bf16x8 pa2, bf16x8 pa3) {
  const s16x4 l0 = tr_read<v_rd_off<NCB>(D0, 0, 0)>(vb), h0 = tr_read<v_rd_off<NCB>(D0, 0, 1)>(vb), l1 = tr_read<v_rd_off<NCB>(D0, 1, 0)>(vb), h1 = tr_read<v_rd_off<NCB>(D0, 1, 1)>(vb);
  const s16x4 l2 = tr_read<v_rd_off<NCB>(D0, 2, 0)>(vb), h2 = tr_read<v_rd_off<NCB>(D0, 2, 1)>(vb), l3 = tr_read<v_rd_off<NCB>(D0, 3, 0)>(vb), h3 = tr_read<v_rd_off<NCB>(D0, 3, 1)>(vb);
  asm volatile("s_waitcnt lgkmcnt(0)" ::: "memory"); ATT_SBAR();
#define PK(L, H) (bf16x8){L[0], L[1], L[2], L[3], H[0], H[1], H[2], H[3]}
  od = __builtin_amdgcn_mfma_f32_32x32x16_bf16(pa0, PK(l0, h0), od, 0, 0, 0);
  od = __builtin_amdgcn_mfma_f32_32x32x16_bf16(pa1, PK(l1, h1), od, 0, 0, 0);
  od = __builtin_amdgcn_mfma_f32_32x32x16_bf16(pa2, PK(l2, h2), od, 0, 0, 0);
  od = __builtin_amdgcn_mfma_f32_32x32x16_bf16(pa3, PK(l3, h3), od, 0, 0, 0);
#undef PK
}
struct Src { const bf16* kc; const bf16* vc; int cp; const bf16* kl; const bf16* vl; int lp; int nctx; int nt; int lat0; int q0; bool mask; };
constexpr int L_K = 0, L_V = 16384, L_WS = 32768, L_CMB = 65536;

template <int KW, int DV, bool ZS>
__device__ __forceinline__ void attn_unit(LAS unsigned char* lds, const bf16* Qrow0  , int qpitch, const Src& S,
                                          float sink_l2  , float lam, f32x16* o, int tid, int wave, int lane) {
  constexpr int NCB = DV / 32, NPK = KW / 64, NPV = DV / 64;
  const int r32 = lane & 31, hi = lane >> 5;
  const int qoff = ZS ? 32 * (wave >> 1) : 32 * wave; const int kcolB = ZS ? (wave & 1) * 128 : 0;
  LAS float* wsf = (LAS float*)(lds + L_WS) + wave * 64; LAS float* li_l = wsf; LAS float* al_l = wsf + 32;
  float m_reg = -1e30f, l_reg = 0.f;
#pragma unroll
  for (int d = 0; d < NCB; ++d) o[d] = f32x16{};
  bf16x8 qr[4];
  { const bf16* Qw = Qrow0 + (size_t)(qoff + r32) * qpitch + (ZS ? (wave & 1) * 64 : 0) + hi * 8;
#pragma unroll
    for (int d0 = 0; d0 < 4; ++d0) qr[d0] = *(const bf16x8*)(Qw + d0 * 16); }
  const int ksr = (KW == 64) ? (tid >> 3) : (tid >> 4), ksc = (KW == 64) ? (tid & 7) * 8 : (tid & 15) * 8;
  const int vsr = (DV == 64) ? (tid >> 3) : (tid >> 4), vsc = (DV == 64) ? (tid & 7) * 8 : (tid & 15) * 8;
  const int vb0 = (int)(size_t)(lds + L_V) + v_rd_base(lane);
  bf16x8 kst[NPK], vst[NPV];
#define ATT_LOAD(j) do { const bool cx = (j) < S.nctx; const bf16* kb = cx ? S.kc + (size_t)((j) * 64) * S.cp : S.kl + (size_t)(S.lat0 + ((j) - S.nctx) * 64) * S.lp; \
    const bf16* vbp = cx ? S.vc + (size_t)((j) * 64) * S.cp : S.vl + (size_t)(S.lat0 + ((j) - S.nctx) * 64) * S.lp; const int pt = cx ? S.cp : S.lp; \
    _Pragma("unroll") for (int i = 0; i < NPK; ++i) kst[i] = *(const bf16x8*)(kb + (size_t)(ksr + 32 * i) * pt + ksc); \
    _Pragma("unroll") for (int i = 0; i < NPV; ++i) vst[i] = *(const bf16x8*)(vbp + (size_t)(vsr + 32 * i) * pt + vsc); } while (0)
#define ATT_WRITE() do { \
    _Pragma("unroll") for (int i = 0; i < NPK; ++i) *(LAS bf16x8*)(lds + L_K + kswz<KW>(ksr + 32 * i, ksc * 2)) = kst[i]; \
    _Pragma("unroll") for (int i = 0; i < NPV; ++i) *(LAS bf16x8*)(lds + L_V + v_st<NCB>(vsr + 32 * i, vsc)) = vst[i]; } while (0)
  ATT_LOAD(0);
  for (int j = 0; j < S.nt; ++j) {
    __syncthreads();
    ATT_WRITE();
    __syncthreads();
    if (j + 1 < S.nt) ATT_LOAD(j + 1);
    f32x16 p0, p1; float alpha; bf16x8 pa0, pa1, pa2, pa3;
    ATT_SBAR(); qkt<KW>(p0, p1, lds + L_K, kcolB, qr, r32, hi);
    if (S.mask && j >= S.nctx) {
      const int qpos = S.q0 + qoff + r32, kb0 = S.lat0 + (j - S.nctx) * 64;
#pragma unroll
      for (int r = 0; r < 16; ++r) { const int k0 = kb0 + crow(r, hi) - qpos; if (k0 > 128 || k0 < -128) p0[r] = -1e30f; const int k1 = k0 + 32; if (k1 > 128 || k1 < -128) p1[r] = -1e30f; }
    }
    partialSM(p0, p1, m_reg, alpha);
    if (__any(alpha < 1.f)) { if (hi == 0) al_l[r32] = alpha; asm volatile("s_waitcnt lgkmcnt(0)" ::: "memory");
#pragma unroll
      for (int d = 0; d < NCB; ++d)
#pragma unroll
        for (int r = 0; r < 16; ++r) o[d][r] *= al_l[crow(r, hi)]; }
    finishSM(p0, p1, alpha, l_reg, pa0, pa1, pa2, pa3); ATT_SBAR();
    pv_one<NCB, 0>(o[0], vb0, pa0, pa1, pa2, pa3); pv_one<NCB, 1>(o[1], vb0, pa0, pa1, pa2, pa3);
    if constexpr (NCB == 4) { pv_one<NCB, 2>(o[2], vb0, pa0, pa1, pa2, pa3); pv_one<NCB, 3>(o[3], vb0, pa0, pa1, pa2, pa3); }
  }
#undef ATT_LOAD
#undef ATT_WRITE
  float lt = l_reg + __builtin_amdgcn_exp2f(sink_l2 - m_reg * CSC);
  if (hi == 0) li_l[r32] = lt; asm volatile("s_waitcnt lgkmcnt(0)" ::: "memory");
  float rli[16];
#pragma unroll
  for (int r = 0; r < 16; ++r) rli[r] = __builtin_amdgcn_rcpf(li_l[crow(r, hi)]);
#pragma unroll
  for (int d = 0; d < NCB; ++d)
#pragma unroll
    for (int r = 0; r < 16; ++r) o[d][r] *= rli[r];
  if constexpr (ZS) {
    LAS float* cb = (LAS float*)(lds + L_CMB) + (wave >> 1) * 4096;
    if (wave & 1) {
#pragma unroll
      for (int d = 0; d < NCB; ++d)
#pragma unroll
        for (int r = 0; r < 16; ++r) cb[(d * 16 + r) * 64 + lane] = o[d][r];
    }
    __syncthreads();
    if (!(wave & 1)) {
#pragma unroll
      for (int d = 0; d < NCB; ++d)
#pragma unroll
        for (int r = 0; r < 16; ++r) o[d][r] -= lam * cb[(d * 16 + r) * 64 + lane];
    }
  }
}
#undef ATT_SBAR
}
namespace rw {
typedef short bf16x8 __attribute__((ext_vector_type(8)));
typedef short bf16x4 __attribute__((ext_vector_type(4)));
typedef float f32x4 __attribute__((ext_vector_type(4)));
constexpr int R_KK = 0, R_RR = 2048, R_GG = 4096, R_VP = 8192, R_AKK = 10240, R_TI = 11264, R_MR = 12288, R_WC = 13312, REC_BYTES = 13568;
constexpr int RS = 72;
constexpr int S_R = 0, S_K = 4096, A_K = 8192, A_R = 10496, A_B = 12800, A_E = 15104, S_TW = 17408, S_AL = 19712, S_MU = 22016, SCR_BYTES = 23552;
typedef float f32x2_t __attribute__((ext_vector_type(2))); typedef __bf16 bf16x2_t __attribute__((ext_vector_type(2)));
__device__ __forceinline__ unsigned cvtpk(float lo, float hi) { const f32x2_t v = {lo, hi}; const bf16x2_t b = __builtin_convertvector(v, bf16x2_t); return __builtin_bit_cast(unsigned, b); }
__device__ __forceinline__ unsigned short f2b(float f) { return (unsigned short)cvtpk(f, f); }
typedef unsigned u32x2 __attribute__((ext_vector_type(2)));
__device__ __forceinline__ bf16x4 pack4(float a, float b, float c, float d) { const u32x2 w = {cvtpk(a, b), cvtpk(c, d)}; return __builtin_bit_cast(bf16x4, w); }
__device__ __forceinline__ bf16x8 packlo(const f32x4& c) { const bf16x4 p = pack4(c[0], c[1], c[2], c[3]); return (bf16x8){p[0], p[1], p[2], p[3], 0, 0, 0, 0}; }
__device__ __forceinline__ f32x4 mm16(const f32x4& xt, const f32x4& y) { return __builtin_amdgcn_mfma_f32_16x16x32_bf16(packlo(xt), packlo(y), (f32x4){0.f, 0.f, 0.f, 0.f}, 0, 0, 0); }

struct Consts { bf16x8 w2f[2], a2f[2]; float kk4[4]; float w0s, a0s, kas, rks; };
struct Win { bf16x8 a[3], m[3], n[3]; };
__device__ __forceinline__ void load_consts(const Params& P, LAS unsigned char* scr, int h, int dir, int gtid, int lane, Consts& K) {
    const int wq = (gtid >> 6), l15 = lane & 15, g = lane >> 4, c2 = h * 64 + 16 * wq + l15;
    K.w0s = P.in[I_W0][dir * 512 + c2]; K.a0s = P.in[I_A0][dir * 512 + c2]; K.kas = P.in[I_KA][c2]; K.rks = P.in[I_RK][c2];
#pragma unroll
    for (int nt = 0; nt < 4; ++nt) K.kk4[nt] = P.in[I_KK][h * 64 + 16 * nt + l15];
    const bf16* w2t = (const bf16*)(P.ws + WS_LORA) + ((size_t)(dir * 8 + h) * 64 + 16 * wq + l15) * 64; const bf16* a2t = w2t + 65536;
#pragma unroll
    for (int ks = 0; ks < 2; ++ks) { K.w2f[ks] = *(const bf16x8*)(w2t + 32 * ks + 8 * g); K.a2f[ks] = *(const bf16x8*)(a2t + 32 * ks + 8 * g); }
    LAS float* smu = (LAS float*)(scr + S_MU); const float* mu = P.in[I_MU];
    for (int i = gtid; i < 320; i += 256) { const int kind = i >> 6, cc = i & 63; smu[i] = mu[kind < 3 ? kind * 512 + h * 64 + cc : 1536 + (i - 192)]; }
}
__device__ __forceinline__ void prep_fetch(const Params& P, int rowbase, int T, int t0, int h, int dir, int gtid, Win& W) {
    const bf16* PR = (const bf16*)(P.ws + WS_PROJ);
    const int wqu = __builtin_amdgcn_readfirstlane(gtid >> 6), ln = gtid & 63;
#pragma unroll
    for (int q = 0; q < 3; ++q) { int p = wqu + 4 * q; if (p > 9) p = 9;
        const int kind = p >> 1, tl = ((p & 1) * 64 + ln) >> 3, c8 = (ln & 7) * 8;
        const int col = 1280 + (kind < 3 ? kind * 512 + h * 64 + c8 : 1536 + (kind - 3) * 64 + c8);
        const int tm = dir ? t0 + 15 - tl : t0 + tl; const int ta = dir ? tm + 1 : tm - 1, tn = dir ? tm - 1 : tm + 1;
        const int ca = ta < 0 ? 0 : (ta >= T ? T - 1 : ta), cn = tn < 0 ? 0 : (tn >= T ? T - 1 : tn);
        W.a[q] = *(const bf16x8*)(PR + (size_t)(rowbase + ca) * N0 + col); W.m[q] = *(const bf16x8*)(PR + (size_t)(rowbase + tm) * N0 + col); W.n[q] = *(const bf16x8*)(PR + (size_t)(rowbase + cn) * N0 + col); }
}
__device__ __forceinline__ void prep_chunk(const Params& P, LAS unsigned char* rec, LAS unsigned char* scr, int T, int t0, int dir, const Consts& K, const Win& W,
                                           float* bon_out, int bon_stride, int bon_wstride, int gtid, int lane) {
    const int wq = gtid >> 6, l15 = lane & 15, g = lane >> 4;
    LAS float* sR = (LAS float*)(scr + S_R); LAS float* sK = (LAS float*)(scr + S_K);
    LAS unsigned short* sTW = (LAS unsigned short*)(scr + S_TW); LAS unsigned short* sAL = (LAS unsigned short*)(scr + S_AL);
    LAS unsigned short* aK = (LAS unsigned short*)(scr + A_K); LAS unsigned short* aR = (LAS unsigned short*)(scr + A_R);
    LAS unsigned short* aB = (LAS unsigned short*)(scr + A_B); LAS unsigned short* aE = (LAS unsigned short*)(scr + A_E);
    const LAS float* smu = (const LAS float*)(scr + S_MU);
    {   const int wqu = __builtin_amdgcn_readfirstlane(gtid >> 6), ln = gtid & 63;
#pragma unroll
        for (int q = 0; q < 3; ++q) { const int p = wqu + 4 * q;
            if (p < 10) { const int kind = p >> 1, tl = ((p & 1) * 64 + ln) >> 3, c8 = (ln & 7) * 8;
                const int tm = dir ? t0 + 15 - tl : t0 + tl; const int ta = dir ? tm + 1 : tm - 1, tn = dir ? tm - 1 : tm + 1;
                const float ma = (ta >= 0 && ta < T) ? 0.5f : 0.f, mn = (tn >= 0 && tn < T) ? 0.5f : 0.f;
                const f32x4 mu0 = *(const LAS f32x4*)(smu + kind * 64 + c8), mu1 = *(const LAS f32x4*)(smu + kind * 64 + c8 + 4);
                float x[8];
#pragma unroll
                for (int e = 0; e < 8; ++e) { const float pm = bf2f((bf16)W.m[q][e]); x[e] = pm + (ma * bf2f((bf16)W.a[q][e]) + mn * bf2f((bf16)W.n[q][e]) - pm) * (e < 4 ? mu0[e] : mu1[e - 4]); }
                if (kind == 0) { *(LAS f32x4*)(sR + tl * 64 + c8) = (f32x4){x[0], x[1], x[2], x[3]}; *(LAS f32x4*)(sR + tl * 64 + c8 + 4) = (f32x4){x[4], x[5], x[6], x[7]}; }
                else if (kind == 1) { *(LAS f32x4*)(sK + tl * 64 + c8) = (f32x4){x[0], x[1], x[2], x[3]}; *(LAS f32x4*)(sK + tl * 64 + c8 + 4) = (f32x4){x[4], x[5], x[6], x[7]}; }
                else if (kind == 2) { LAS unsigned short* vp = (LAS unsigned short*)(rec + R_VP);
#pragma unroll
                    for (int e = 0; e < 8; ++e) vp[((c8 + e) * 4 + (tl >> 2)) * 4 + (tl & 3)] = f2b(x[e]); }
                else if (kind == 3) { float th[8];
#pragma unroll
                    for (int e = 0; e < 8; ++e) th[e] = 1.f - 2.f * __builtin_amdgcn_rcpf(1.f + __expf(2.f * x[e]));
                    *(LAS bf16x4*)(sTW + tl * RS + c8) = pack4(th[0], th[1], th[2], th[3]); *(LAS bf16x4*)(sTW + tl * RS + c8 + 4) = pack4(th[4], th[5], th[6], th[7]); }
                else { *(LAS bf16x4*)(sAL + tl * RS + c8) = pack4(x[0], x[1], x[2], x[3]); *(LAS bf16x4*)(sAL + tl * RS + c8 + 4) = pack4(x[4], x[5], x[6], x[7]); } } } }
    __syncthreads();
    {   const int ch = 16 * wq + l15;
        f32x4 wp = {0.f, 0.f, 0.f, 0.f}, ap = {0.f, 0.f, 0.f, 0.f};
#pragma unroll
        for (int ks = 0; ks < 2; ++ks) { const bf16x8 ta = *(const LAS bf16x8*)(sTW + l15 * RS + 32 * ks + 8 * g), aa = *(const LAS bf16x8*)(sAL + l15 * RS + 32 * ks + 8 * g);
            wp = __builtin_amdgcn_mfma_f32_16x16x32_bf16(ta, K.w2f[ks], wp, 0, 0, 0); ap = __builtin_amdgcn_mfma_f32_16x16x32_bf16(aa, K.a2f[ks], ap, 0, 0, 0); }
        float e[4], av[4], rv[4], kkr[4], ke[4], cum[4], ssq[4], bs[4];
#pragma unroll
        for (int i = 0; i < 4; ++i) { const int tl = 4 * g + i;
            float kq[4];
#pragma unroll
            for (int nt = 0; nt < 4; ++nt) kq[nt] = sK[tl * 64 + 16 * nt + l15];
            ssq[i] = 0.f;
#pragma unroll
            for (int nt = 0; nt < 4; ++nt) { const float t2 = kq[nt] * K.kk4[nt]; ssq[i] += t2 * t2; }
            const float kv = (wq == 0) ? kq[0] : (wq == 1) ? kq[1] : (wq == 2) ? kq[2] : kq[3];
            const float kkc = (wq == 0) ? K.kk4[0] : (wq == 1) ? K.kk4[1] : (wq == 2) ? K.kk4[2] : K.kk4[3];
            rv[i] = sR[tl * 64 + ch];
            const float wl = -(K.w0s + wp[i]); const float sp = fmaxf(wl, 0.f) + __logf(1.f + __expf(-fabsf(wl)));
            e[i] = __expf(-sp - 0.5f);
            av[i] = __builtin_amdgcn_rcpf(1.f + __expf(-(K.a0s + ap[i])));
            kkr[i] = kv * kkc; ke[i] = kv * (1.f + (av[i] - 1.f) * K.kas);
            bs[i] = rv[i] * ke[i] * K.rks; }
#pragma unroll
        for (int i = 0; i < 4; ++i) {
#pragma unroll
            for (int o = 1; o < 16; o <<= 1) { ssq[i] += __shfl_xor(ssq[i], o); bs[i] += __shfl_xor(bs[i], o); }
            if (l15 == 0) bon_out[wq * bon_wstride + (4 * g + i) * bon_stride] = bs[i]; }
        cum[0] = e[0]; cum[1] = cum[0] + e[1]; cum[2] = cum[1] + e[2]; cum[3] = cum[2] + e[3];
        const float tot = cum[3];
        const float t0s = __shfl(tot, l15), t1s = __shfl(tot, l15 + 16), t2s = __shfl(tot, l15 + 32), t3s = __shfl(tot, l15 + 48);
        const float pre = (g > 0 ? t0s : 0.f) + (g > 1 ? t1s : 0.f) + (g > 2 ? t2s : 0.f);
        if (g == 0) *(LAS float*)(rec + R_WC + ch * 4) = __expf(-(t0s + t1s + t2s + t3s));
        const int ks = ch >> 5, hb = (ch >> 4) & 1, gk = (ch >> 2) & 3, ik = ch & 3;
        LAS unsigned short* KKp = (LAS unsigned short*)(rec + R_KK); LAS unsigned short* RRp = (LAS unsigned short*)(rec + R_RR);
        float bt[4], et[4];
#pragma unroll
        for (int i = 0; i < 4; ++i) { const int tl = 4 * g + i; const float cm = cum[i] + pre;
            const float kk = kkr[i] * __builtin_amdgcn_rsqf(fmaxf(ssq[i], 1e-24f));
            const float Wt = __expf(-cm), Wp = __expf(-(cm - e[i])), iW = __expf(cm);
            const float ktv = kk * Wp, rtv = rv[i] * Wt; bt[i] = kk * av[i] * iW; et[i] = ke[i] * iW;
            const unsigned short kb = f2b(ktv), rb = f2b(rtv);
            aK[tl * RS + ch] = kb; aR[tl * RS + ch] = rb; aB[tl * RS + ch] = f2b(bt[i]); aE[tl * RS + ch] = f2b(et[i]);
            KKp[((tl * 2 + ks) * 4 + gk) * 8 + 4 * hb + ik] = kb; RRp[((tl * 2 + ks) * 4 + gk) * 8 + 4 * hb + ik] = rb; }
        *(LAS bf16x4*)(rec + R_GG + (ch * 4 + g) * 16) = pack4(bt[0], bt[1], bt[2], bt[3]);
        *(LAS bf16x4*)(rec + R_GG + (ch * 4 + g) * 16 + 8) = pack4(et[0], et[1], et[2], et[3]); }
    __syncthreads();
    {   const LAS unsigned short* ra = (wq == 0) ? aB : (wq & 1) ? aE : aB; const LAS unsigned short* cb = (wq < 2) ? aK : aR;
        f32x4 acc = {0.f, 0.f, 0.f, 0.f}, acct = {0.f, 0.f, 0.f, 0.f};
        bf16x8 fa[2], fb[2];
#pragma unroll
        for (int ks = 0; ks < 2; ++ks) { fa[ks] = *(const LAS bf16x8*)(ra + l15 * RS + 32 * ks + 8 * g); fb[ks] = *(const LAS bf16x8*)(cb + l15 * RS + 32 * ks + 8 * g); }
#pragma unroll
        for (int ks = 0; ks < 2; ++ks) acc = __builtin_amdgcn_mfma_f32_16x16x32_bf16(fa[ks], fb[ks], acc, 0, 0, 0);
#pragma unroll
        for (int i = 0; i < 4; ++i) { const int s = 4 * g + i; const bool keep = (wq < 2) ? (s < l15) : (s <= l15); if (!keep) acc[i] = 0.f; }
        if (wq == 0) {
#pragma unroll
            for (int ks = 0; ks < 2; ++ks) acct = __builtin_amdgcn_mfma_f32_16x16x32_bf16(fb[ks], fa[ks], acct, 0, 0, 0);
            f32x4 idm;
#pragma unroll
            for (int i = 0; i < 4; ++i) { const int s = 4 * g + i; if (!(l15 < s)) acct[i] = 0.f; idm[i] = (s == l15) ? 1.f : 0.f; }
            const f32x4 n2 = mm16(acct, acc), n2t = mm16(acc, acct);
            const f32x4 n4 = mm16(n2t, n2), n4t = mm16(n2, n2t);
            const f32x4 n8 = mm16(n4t, n4);
            const f32x4 r1 = mm16(idm + n4t, idm + n8);
            const f32x4 r2 = mm16(idm + n2t, r1);
            const f32x4 ti = mm16(idm - acct, r2);
            *(LAS bf16x4*)(rec + R_TI + (l15 * 4 + g) * 16) = pack4(-ti[0], -ti[1], -ti[2], -ti[3]); *(LAS bf16x4*)(rec + R_TI + (l15 * 4 + g) * 16 + 8) = pack4(0.f, 0.f, 0.f, 0.f); }
        else if (wq == 1) { *(LAS bf16x4*)(rec + R_AKK + (l15 * 4 + g) * 16) = pack4(0.f, 0.f, 0.f, 0.f); *(LAS bf16x4*)(rec + R_AKK + (l15 * 4 + g) * 16 + 8) = pack4(acc[0], acc[1], acc[2], acc[3]); }
        else if (wq == 2) *(LAS bf16x4*)(rec + R_MR + (l15 * 4 + g) * 16) = pack4(acc[0], acc[1], acc[2], acc[3]);
        else *(LAS bf16x4*)(rec + R_MR + (l15 * 4 + g) * 16 + 8) = pack4(acc[0], acc[1], acc[2], acc[3]); }
    __syncthreads();
}
__device__ __forceinline__ void scan_chunk(const LAS unsigned char* rec, f32x4 (&acc)[4], float* ydst, int ystep, int wq, int lane) {
    const int l15 = lane & 15, g = lane >> 4;
    const bf16x8 kk0 = *(const LAS bf16x8*)(rec + R_KK + l15 * 128 + g * 16), kk1 = *(const LAS bf16x8*)(rec + R_KK + l15 * 128 + 64 + g * 16);
    const bf16x8 rr0 = *(const LAS bf16x8*)(rec + R_RR + l15 * 128 + g * 16), rr1 = *(const LAS bf16x8*)(rec + R_RR + l15 * 128 + 64 + g * 16);
    const bf16x8 akk = *(const LAS bf16x8*)(rec + R_AKK + (l15 * 4 + g) * 16), ti = *(const LAS bf16x8*)(rec + R_TI + (l15 * 4 + g) * 16), mr = *(const LAS bf16x8*)(rec + R_MR + (l15 * 4 + g) * 16);
    const bf16x4 vp = *(const LAS bf16x4*)(rec + R_VP + ((16 * wq + l15) * 4 + g) * 8);
    bf16x8 sf0, sf1;
    { const bf16x4 a = pack4(acc[0][0], acc[0][1], acc[0][2], acc[0][3]), b = pack4(acc[1][0], acc[1][1], acc[1][2], acc[1][3]);
      const bf16x4 c = pack4(acc[2][0], acc[2][1], acc[2][2], acc[2][3]), d = pack4(acc[3][0], acc[3][1], acc[3][2], acc[3][3]);
      sf0 = (bf16x8){a[0], a[1], a[2], a[3], b[0], b[1], b[2], b[3]}; sf1 = (bf16x8){c[0], c[1], c[2], c[3], d[0], d[1], d[2], d[3]}; }
    const bf16x8 v0 = (bf16x8){0, 0, 0, 0, vp[0], vp[1], vp[2], vp[3]};
    f32x4 X = {0.f, 0.f, 0.f, 0.f}, Y = {0.f, 0.f, 0.f, 0.f};
    X = __builtin_amdgcn_mfma_f32_16x16x32_bf16(kk0, sf0, X, 0, 0, 0); X = __builtin_amdgcn_mfma_f32_16x16x32_bf16(kk1, sf1, X, 0, 0, 0); X = __builtin_amdgcn_mfma_f32_16x16x32_bf16(akk, v0, X, 0, 0, 0);
    Y = __builtin_amdgcn_mfma_f32_16x16x32_bf16(rr0, sf0, Y, 0, 0, 0); Y = __builtin_amdgcn_mfma_f32_16x16x32_bf16(rr1, sf1, Y, 0, 0, 0);
    const bf16x4 xb = pack4(X[0], X[1], X[2], X[3]);
    const bf16x8 xf = (bf16x8){xb[0], xb[1], xb[2], xb[3], 0, 0, 0, 0};
    f32x4 U = {0.f, 0.f, 0.f, 0.f};
    U = __builtin_amdgcn_mfma_f32_16x16x32_bf16(ti, xf, U, 0, 0, 0);
    const bf16x4 ub = pack4(U[0], U[1], U[2], U[3]);
    const bf16x8 uv = (bf16x8){ub[0], ub[1], ub[2], ub[3], vp[0], vp[1], vp[2], vp[3]};
    Y = __builtin_amdgcn_mfma_f32_16x16x32_bf16(mr, uv, Y, 0, 0, 0);
#pragma unroll
    for (int mt = 0; mt < 4; ++mt) { const bf16x8 gg = *(const LAS bf16x8*)(rec + R_GG + ((16 * mt + l15) * 4 + g) * 16); const f32x4 wc = *(const LAS f32x4*)(rec + R_WC + (16 * mt + 4 * g) * 4);
        acc[mt] = __builtin_amdgcn_mfma_f32_16x16x32_bf16(gg, uv, acc[mt], 0, 0, 0); acc[mt] = acc[mt] * wc; }
#pragma unroll
    for (int i = 0; i < 4; ++i) ydst[(ptrdiff_t)(4 * g + i) * ystep + 16 * wq + l15] = Y[i];
}
__device__ __forceinline__ void post_item(const Params& P, int r, int t, int T, int h, int part, float bon) {
    const bf16* PR = (const bf16*)(P.ws + WS_PROJ); bf16* MIX = (bf16*)(P.ws + WS_MIX);
    const int c0 = h * 64 + part * 32;
    const f32x4* yf = (const f32x4*)((const float*)(P.ws + WS_YF) + (size_t)r * 512 + c0); const f32x4* yb = (const f32x4*)((const float*)(P.ws + WS_YB) + (size_t)r * 512 + c0);
    float y[32];
#pragma unroll
    for (int q = 0; q < 8; ++q) { const f32x4 a = yf[q], b = yb[q]; y[4 * q] = a[0] + b[0]; y[4 * q + 1] = a[1] + b[1]; y[4 * q + 2] = a[2] + b[2]; y[4 * q + 3] = a[3] + b[3]; }
    const bf16* p0 = PR + (size_t)r * N0; const bool hp = t > 0, hn = t + 1 < T;
    const bf16* pp = p0 - (hp ? N0 : 0); const bf16* pn = p0 + (hn ? N0 : 0); const float mp = hp ? 1.f : 0.f, mn = hn ? 1.f : 0.f;
    float s = 0.f;
#pragma unroll
    for (int i = 0; i < 32; ++i) s += y[i];
    s += __shfl_xor(s, 1); const float mean = s * (1.f / 64.f);
    float q2 = 0.f;
#pragma unroll
    for (int i = 0; i < 32; ++i) { y[i] -= mean; q2 += y[i] * y[i]; }
    q2 += __shfl_xor(q2, 1); const float rstd = __builtin_amdgcn_rsqf(q2 * (1.f / 64.f) + 64e-5f);
    const float* lnw = P.in[I_LNW] + c0; const float* lnb = P.in[I_LNB] + c0; const float* muv = P.in[I_MU] + 1024 + c0;
    v4u* dst = (v4u*)(MIX + (size_t)r * D + 512 + c0);
#pragma unroll
    for (int q = 0; q < 4; ++q) {
        const bf16x8 vc = *(const bf16x8*)(p0 + 2304 + c0 + 8 * q), gb = *(const bf16x8*)(p0 + 2944 + c0 + 8 * q), vp = *(const bf16x8*)(pp + 2304 + c0 + 8 * q), vn = *(const bf16x8*)(pn + 2304 + c0 + 8 * q);
        float o8[8];
#pragma unroll
        for (int e = 0; e < 8; ++e) { const int ii = 8 * q + e; const float pc = bf2f((bf16)vc[e]), pq = bf2f((bf16)vp[e]) * mp, pm = bf2f((bf16)vn[e]) * mn;
            const float xv = pc + (0.5f * (pq + pm) - pc) * muv[ii]; const float g = bf2f((bf16)gb[e]);
            o8[e] = (y[ii] * rstd * lnw[ii] + lnb[ii] + bon * xv) * silu_f(g); }
        dst[q] = (v4u){pk2(o8[0], o8[1]), pk2(o8[2], o8[3]), pk2(o8[4], o8[5]), pk2(o8[6], o8[7])};
    }
}
}
__device__ __forceinline__ void p6_mid(const Params& P, LAS unsigned char* lds, int G, int vcu, int wave, int lane, int tid) {
    LAS float* gp = (LAS float*)lds; LAS float* gs = gp + 3 * 1024; LAS float* sh = gs + 3 * 1024;
    for (int i = tid; i < 3 * 1024; i += 512) { const int j = i >> 10, k = i & 1023;
        gp[i] = mod_val(P, 0, j, 2048 + k) * P.in[I_NPOST][k];
        gs[i] = P.in[I_NPRE][1024 + k] * (1.f + mod_val(P, 1, j, 1024 + k)); sh[i] = mod_val(P, 1, j, k); }
    __syncthreads();
    const int gw = vcu * NWAVES + wave, NGW = G * NWAVES;
    bf16* XN = (bf16*)(P.ws + WS_XN); const float* Y = (const float*)(P.ws + WS_Y);
    for (int r = gw; r < M; r += NGW) {
        const f32x4* xr = (const f32x4*)xrow(P, r) + lane; const f32x4* yr = (const f32x4*)(Y + (size_t)r * D) + lane; const int j = modidx(r);
        f32x4 y[4], x[4]; float s = 0.f;
#pragma unroll
        for (int q = 0; q < 4; ++q) { y[q] = yr[64 * q]; x[q] = xr[64 * q]; s += (y[q].x * y[q].x + y[q].y * y[q].y) + (y[q].z * y[q].z + y[q].w * y[q].w); }
        const float rinv = 1.f / sqrtf(wave_sum(s) * (1.f / D) + NORM_EPS);
        float s1 = 0.f; f32x4* orow = (f32x4*)(P.out + OUT_Y + (size_t)r * D) + lane;
#pragma unroll
        for (int q = 0; q < 4; ++q) { const LAS float* g = gp + j * 1024 + 256 * q + 4 * lane;
            x[q].x += g[0] * y[q].x * rinv; x[q].y += g[1] * y[q].y * rinv; x[q].z += g[2] * y[q].z * rinv; x[q].w += g[3] * y[q].w * rinv;
            orow[64 * q] = x[q]; s1 += (x[q].x * x[q].x + x[q].y * x[q].y) + (x[q].z * x[q].z + x[q].w * x[q].w); }
        const float rinv1 = 1.f / sqrtf(wave_sum(s1) * (1.f / D) + NORM_EPS);
        unsigned long long* o8 = (unsigned long long*)(XN + (size_t)r * D) + lane;
#pragma unroll
        for (int q = 0; q < 4; ++q) { const int k = 256 * q + 4 * lane; const LAS float* g = gs + j * 1024 + k; const LAS float* b = sh + j * 1024 + k;
            const float o0 = x[q].x * rinv1 * g[0] + b[0], o1 = x[q].y * rinv1 * g[1] + b[1], o2 = x[q].z * rinv1 * g[2] + b[2], o3 = x[q].w * rinv1 * g[3] + b[3];
            o8[64 * q] = (unsigned long long)pk2(o0, o1) | ((unsigned long long)pk2(o2, o3) << 32); }
    }
    __syncthreads();
}
__device__ __forceinline__ void p10_final(const Params& P, LAS unsigned char* lds, int G, int vcu, int wave, int lane, int tid) {
    LAS float* gp = (LAS float*)lds;
    for (int i = tid; i < 3 * 1024; i += 512) { const int j = i >> 10, k = i & 1023; gp[i] = mod_val(P, 1, j, 2048 + k) * P.in[I_NPOST][1024 + k]; }
    __syncthreads();
    const int gw = vcu * NWAVES + wave, NGW = G * NWAVES;
    const float* Y = (const float*)(P.ws + WS_Y);
    for (int r = gw; r < M; r += NGW) {
        f32x4* orow = (f32x4*)(P.out + OUT_Y + (size_t)r * D) + lane; const f32x4* yr = (const f32x4*)(Y + (size_t)r * D) + lane; const int j = modidx(r);
        f32x4 y[4], x[4]; float s = 0.f;
#pragma unroll
        for (int q = 0; q < 4; ++q) { y[q] = yr[64 * q]; x[q] = orow[64 * q]; s += (y[q].x * y[q].x + y[q].y * y[q].y) + (y[q].z * y[q].z + y[q].w * y[q].w); }
        const float rinv = 1.f / sqrtf(wave_sum(s) * (1.f / D) + NORM_EPS);
#pragma unroll
        for (int q = 0; q < 4; ++q) { const LAS float* g = gp + j * 1024 + 256 * q + 4 * lane;
            x[q].x += g[0] * y[q].x * rinv; x[q].y += g[1] * y[q].y * rinv; x[q].z += g[2] * y[q].z * rinv; x[q].w += g[3] * y[q].w * rinv;
            orow[64 * q] = x[q]; }
    }
    __syncthreads();
}
__device__ __forceinline__ void attnA_unit(const Params& P, LAS unsigned char* lds, bool sample, int b, int h, int qb, int tid, int wave, int lane) {
    asm volatile("" : "+v"(tid), "+v"(lane));
    const bf16* PR = (const bf16*)(P.ws + WS_PROJ); bf16* MIX = (bf16*)(P.ws + WS_MIX);
    const int g = h >> 2; att::Src S; int rowQ0;
    if (sample) { rowQ0 = MP + b * 2048 + qb * 256;
        S.kc = (const bf16*)(P.ws + WS_CAK) + (size_t)b * 256 * 128 + g * 64; S.vc = (const bf16*)(P.ws + WS_CAV) + (size_t)b * 256 * 128 + g * 64; S.cp = 128; S.nctx = 4;
        S.kl = PR + (size_t)(MP + b * 2048) * N0 + 512 + g * 64; S.vl = PR + (size_t)(MP + b * 2048) * N0 + 640 + g * 64; S.lp = N0;
        const int k0 = qb * 256 - 128 < 0 ? 0 : qb * 256 - 128, k1 = qb * 256 + 384 > 2048 ? 2048 : qb * 256 + 384;
        S.lat0 = k0; S.nt = 4 + (k1 - k0) / 64; S.q0 = qb * 256; S.mask = true;
    } else { rowQ0 = b * 256;
        S.kc = nullptr; S.vc = nullptr; S.cp = 0; S.nctx = 0; S.kl = PR + (size_t)(b * 256) * N0 + 512 + g * 64; S.vl = PR + (size_t)(b * 256) * N0 + 640 + g * 64; S.lp = N0;
        S.lat0 = 0; S.nt = 4; S.q0 = 0; S.mask = false; }
    att::f32x16 o[2];
    att::attn_unit<64, 64, false>(lds, PR + (size_t)rowQ0 * N0 + h * 64, N0, S, P.in[I_SINK][h] * 1.4426950408889634f, 0.f, o, tid, wave, lane);
    const int r32 = lane & 31, hi = lane >> 5;
#pragma unroll
    for (int r = 0; r < 16; ++r) { const int row = rowQ0 + 32 * wave + att::crow(r, hi);
#pragma unroll
        for (int d = 0; d < 2; ++d) { const int col = h * 64 + 32 * d + r32; const float ga = bf2f(PR[(size_t)row * N0 + 768 + col]);
            MIX[(size_t)row * D + col] = (bf16)f2bf(o[d][r] * silu_f(ga)); } }
}
__device__ __forceinline__ void attnC_unit(const Params& P, LAS unsigned char* lds, bool sample, int b, int h, int qb, float lam, int tid, int wave, int lane) {
    asm volatile("" : "+v"(tid), "+v"(lane));
    const bf16* PR = (const bf16*)(P.ws + WS_PROJ); bf16* MIX = (bf16*)(P.ws + WS_MIX);
    att::Src S; int rowQ0;
    if (sample) { rowQ0 = MP + b * 2048 + qb * 128;
        S.kc = (const bf16*)(P.ws + WS_CCK) + (size_t)b * 256 * 1024 + h * 128; S.vc = (const bf16*)(P.ws + WS_CCV) + (size_t)b * 256 * 1024 + h * 128; S.cp = 1024; S.nctx = 4;
        S.kl = PR + (size_t)(MP + b * 2048) * N1 + 1024 + h * 128; S.vl = PR + (size_t)(MP + b * 2048) * N1 + 2048 + h * 128; S.lp = N1; S.lat0 = 0; S.nt = 36; S.q0 = qb * 128; S.mask = false;
    } else { rowQ0 = b * 256 + qb * 128;
        S.kc = nullptr; S.vc = nullptr; S.cp = 0; S.nctx = 0; S.kl = PR + (size_t)(b * 256) * N1 + 1024 + h * 128; S.vl = PR + (size_t)(b * 256) * N1 + 2048 + h * 128; S.lp = N1;
        S.lat0 = 0; S.nt = 4; S.q0 = qb * 128; S.mask = false; }
    att::f32x16 o[4];
    att::attn_unit<128, 128, true>(lds, PR + (size_t)rowQ0 * N1 + h * 128, N1, S, -INFINITY, lam, o, tid, wave, lane);
    if (!(wave & 1)) {
        const int r32 = lane & 31, hi = lane >> 5; const float sc = 1.f - 0.35550906759f;
        float rs[16];
#pragma unroll
        for (int r = 0; r < 16; ++r) { float s = o[0][r] * o[0][r] + o[1][r] * o[1][r] + o[2][r] * o[2][r] + o[3][r] * o[3][r];
            s += __shfl_xor(s, 1); s += __shfl_xor(s, 2); s += __shfl_xor(s, 4); s += __shfl_xor(s, 8); s += __shfl_xor(s, 16);
            rs[r] = sc / sqrtf(s * (1.f / 128.f) + 1e-5f); }
#pragma unroll
        for (int r = 0; r < 16; ++r) { const int row = rowQ0 + 32 * (wave >> 1) + att::crow(r, hi);
#pragma unroll
            for (int d = 0; d < 4; ++d) { const int cc = 32 * d + r32; const float gc = bf2f(PR[(size_t)row * N1 + 3072 + h * 128 + cc]);
                MIX[(size_t)row * D + h * 128 + cc] = (bf16)f2bf(o[d][r] * rs[r] * P.in[I_SUBLN][cc] * silu_f(gc)); } }
    }
}
constexpr int RW_REC1 = 27136  , RW_SCR0 = 57344, RW_BON = 106496;
__device__ __forceinline__ void rw_prep_item_sample(const Params& P, LAS unsigned char* lds, int b, int cidx, int h, int tid, int lane) {
    asm volatile("" : "+v"(tid), "+v"(lane));
    const int dir = tid >> 8, gtid = tid & 255;
    LAS unsigned char* rec = lds + dir * rw::REC_BYTES; LAS unsigned char* scr = lds + RW_SCR0 + dir * rw::SCR_BYTES;
    rw::Consts K; rw::load_consts(P, scr, h, dir, gtid, lane, K);
    const int t0 = cidx * 16;
    rw::Win W; rw::prep_fetch(P, MP + b * 2048, 2048, t0, h, dir, gtid, W);
    float* bon = (float*)(P.ws + WS_BONUS) + (size_t)((dir * 2 + b) * 8 + h) * 4 * 2048 + (dir ? t0 + 15 : t0);
    __syncthreads();
    rw::prep_chunk(P, rec, scr, 2048, t0, dir, K, W, bon, dir ? -1 : 1, 2048, gtid, lane);
    const int ci = dir ? 127 - cidx : cidx;
    v4u* dst = (v4u*)(P.ws + WS_REC + ((size_t)((b * 8 + h) * 2 + dir) * 128 + ci) * rw::REC_BYTES);
    for (int i = gtid; i < rw::REC_BYTES / 16; i += 256) dst[i] = *(const LAS v4u*)(rec + i * 16);
}
__device__ __forceinline__ void rw_scan_unit_sample(const Params& P, LAS unsigned char* lds, int b, int h, int tid, int wave, int lane) {
    asm volatile("" : "+v"(tid), "+v"(lane));
    const int dir = tid >> 8, gtid = tid & 255, wq = (tid >> 6) & 3, l15 = lane & 15, g = lane >> 4;
    LAS unsigned char* buf = lds + dir * 2 * rw::REC_BYTES;
    const v4u* src = (const v4u*)(P.ws + WS_REC + (size_t)((b * 8 + h) * 2 + dir) * 128 * rw::REC_BYTES);
    constexpr int NPC = rw::REC_BYTES / 16;
    rw::f32x4 acc[4];
    { const float* s0 = P.in[I_ST] + ((((size_t)b * 2 + dir) * 8 + h) * 64 + 16 * wq + l15) * 64 + 4 * g;
#pragma unroll
      for (int mt = 0; mt < 4; ++mt) acc[mt] = *(const rw::f32x4*)(s0 + 16 * mt); }
    __syncthreads();
    for (int i = gtid; i < NPC; i += 256) *(LAS v4u*)(buf + i * 16) = src[i];
    __syncthreads();
    float* ybase = (float*)(P.ws + (dir ? WS_YB : WS_YF)) + (size_t)(MP + b * 2048) * 512 + h * 64;
    for (int ci = 0; ci < 128; ++ci) {
        v4u st[4];
        const bool more = ci + 1 < 128;
        if (more) { const v4u* s2 = src + (size_t)(ci + 1) * NPC;
#pragma unroll
            for (int q = 0; q < 4; ++q) { const int i = gtid + 256 * q; if (i < NPC) st[q] = s2[i]; } }
        float* yd = ybase + (size_t)(dir ? 2047 - ci * 16 : ci * 16) * 512;
        rw::scan_chunk(buf + (ci & 1) * rw::REC_BYTES, acc, yd, dir ? -512 : 512, wq, lane);
        if (more) { LAS unsigned char* nb = buf + ((ci + 1) & 1) * rw::REC_BYTES;
#pragma unroll
            for (int q = 0; q < 4; ++q) { const int i = gtid + 256 * q; if (i < NPC) *(LAS v4u*)(nb + i * 16) = st[q]; } }
        __syncthreads();
    }
}
__device__ __forceinline__ void rw_post_sample(const Params& P, int G, int vcu, int tid) {
    const float* BON = (const float*)(P.ws + WS_BONUS);
    for (int it = vcu * 512 + tid; it < MS * 8 * 2; it += G * 512) { const int part = it & 1, h = (it >> 1) & 7, tok = it >> 4, b = tok >> 11, t = tok & 2047;
        const float* bf_ = BON + (size_t)(b * 8 + h) * 4 * 2048 + t; const float* bb_ = BON + (size_t)((2 + b) * 8 + h) * 4 * 2048 + t;
        const float bon = 0.5f * ((bf_[0] + bf_[2048]) + (bf_[4096] + bf_[6144]) + (bb_[0] + bb_[2048]) + (bb_[4096] + bb_[6144]));
        rw::post_item(P, MP + tok, t, 2048, h, part, bon); }
}
__device__ __forceinline__ void rw_unit_prompt(const Params& P, LAS unsigned char* lds, int b, int h, int tid, int wave, int lane) {
    asm volatile("" : "+v"(tid), "+v"(lane));
    const int dir = tid >> 8, gtid = tid & 255, wq = (tid >> 6) & 3, l15 = lane & 15, g = lane >> 4;
    LAS unsigned char* scr = lds + RW_SCR0 + dir * rw::SCR_BYTES;
    float* bonl = (float*)((LAS float*)(lds + RW_BON));
    rw::Consts K; rw::load_consts(P, scr, h, dir, gtid, lane, K);
    rw::f32x4 acc[4];
#pragma unroll
    for (int mt = 0; mt < 4; ++mt) acc[mt] = (rw::f32x4){0.f, 0.f, 0.f, 0.f};
    float* ybase = (float*)(P.ws + (dir ? WS_YB : WS_YF)) + (size_t)(b * 256) * 512 + h * 64;
    rw::Win W; rw::prep_fetch(P, b * 256, 256, dir ? 240 : 0, h, dir, gtid, W);
    __syncthreads();
    for (int ci = 0; ci < 16; ++ci) {
        const int t0 = dir ? 240 - ci * 16 : ci * 16;
        int gt2 = gtid, ln2 = lane; asm volatile("" : "+v"(gt2), "+v"(ln2));
        LAS unsigned char* rec = lds + (ci & 1) * RW_REC1 + dir * rw::REC_BYTES;
        rw::Win W2; const int cn = ci < 15 ? ci + 1 : 15; rw::prep_fetch(P, b * 256, 256, dir ? 240 - cn * 16 : cn * 16, h, dir, gt2, W2);
        rw::prep_chunk(P, rec, scr, 256, t0, dir, K, W, bonl + dir * 1024 + (dir ? t0 + 15 : t0), dir ? -1 : 1, 256, gt2, ln2);
        float* yd = ybase + (size_t)(dir ? t0 + 15 : t0) * 512;
        asm volatile("" : "+v"(ln2));
        rw::scan_chunk(rec, acc, yd, dir ? -512 : 512, wq, ln2);
        W = W2;
    }
    { float* so = P.out + OUT_ST + ((((size_t)b * 2 + dir) * 8 + h) * 64 + 16 * wq + l15) * 64 + 4 * g;
#pragma unroll
      for (int mt = 0; mt < 4; ++mt) *(rw::f32x4*)(so + 16 * mt) = acc[mt]; }
    __threadfence(); __syncthreads();
    { const int t = tid >> 1; const float* bq = bonl + t;
      const float bon = 0.5f * ((bq[0] + bq[256]) + (bq[512] + bq[768]) + (bq[1024] + bq[1280]) + (bq[1536] + bq[1792]));
      rw::post_item(P, b * 256 + t, t, 256, h, tid & 1, bon); }
}
constexpr int NPH = 12;
#ifndef DBL_MASK
#define DBL_MASK 0
#endif
#define REPS(k) ((((DBL_MASK) >> (k)) & 1) + 1)
__global__ void __launch_bounds__(NWAVES * 64, 2) mega_fwd(Params P) {
    extern __shared__ __attribute__((aligned(16))) unsigned char lds_raw[];
    LAS unsigned char* lds = (LAS unsigned char*)lds_raw;
    volatile LAS unsigned* MISC = (volatile LAS unsigned*)(lds + MISC_OFF);
    const int tid = threadIdx.x, lane = tid & 63, wave = __builtin_amdgcn_readfirstlane(tid >> 6);
    const int G = gridDim.x; const int bx = blockIdx.x; const int vcu = (G % 8 == 0) ? (bx % 8) * (G / 8) + bx / 8 : bx;
    gu32* ctl = (gu32*)(P.ws + WS_CTL);
    for (int u = tid; u < (LDS_BYTES - LDSCTL_OFF) / 4; u += NWAVES * 64) ((LAS unsigned*)(lds + LDSCTL_OFF))[u] = 0u;
    __syncthreads();
    XcdBarrier bar = xcd_barrier_post((unsigned*)(ctl + CW_BAR), MISC + 8);
    const int lo = P.ph_lo, hi = P.ph_hi;
#define IN(k) (lo <= (k) && (k) < hi)
#define SEAM(k) do { if (IN(k) && IN((k) + 1)) xcd_barrier(bar); } while (0)

    if (IN(0)) for (int rep_ = 0; rep_ < REPS(0); ++rep_) { p0_prologue(P, lds, G, vcu, wave, lane, tid); } SEAM(0);
    if (IN(1)) for (int rep_ = 0; rep_ < REPS(1); ++rep_) { p1_hprep(P, lds, G, vcu, wave, lane, tid); } SEAM(1);
    if (IN(2)) for (int rep_ = 0; rep_ < REPS(2); ++rep_) {
        pg8::Gemm g{(const pg8::bf16_t*)(P.ws + WS_XN), (const pg8::bf16_t*)(P.ws + WS_WT0), M, N0P, D}; pg8::StaticOrder S; S.init(M, N0P, G, bx);
        pg8::EpiIn E{(pg8::bf16_t*)(P.ws + WS_PROJ), N0, N0, 640, (const float*)(P.ws + WS_ROPE), P.out + OUT_AK, P.out + OUT_AV, 512, 640, 640, 768, 128, 128};
        pg8::gemm_phase<pg8::EpiIn, pg8::StaticOrder, true, true>(lds, g, S, E);
    } SEAM(2);
    if (IN(3)) for (int rep_ = 0; rep_ < REPS(3); ++rep_) {
        for (int u = bx; u < 384 + 2048; u += G) {
            if (u < 128) attnA_unit(P, lds, true, u >> 6, (u >> 3) & 7, u & 7, tid, wave, lane);
            else if (u < 384) { const int i = u - 128; attnA_unit(P, lds, false, i >> 3, i & 7, 0, tid, wave, lane); }
            else { const int i = u - 384; rw_prep_item_sample(P, lds, i >> 10, (i >> 3) & 127, i & 7, tid, lane);
#ifdef PROBE_PREP2
                   __syncthreads(); rw_prep_item_sample(P, lds, i >> 10, (i >> 3) & 127, i & 7, tid, lane);
#endif
            }
            __syncthreads();
        }
    } SEAM(3);
    if (IN(4)) for (int rep_ = 0; rep_ < REPS(4); ++rep_) {
        for (int u = bx; u < 272; u += G) {
            if (u < 16) { rw_scan_unit_sample(P, lds, u >> 3, u & 7, tid, wave, lane);
#ifdef PROBE_SCAN2
                __syncthreads(); rw_scan_unit_sample(P, lds, u >> 3, u & 7, tid, wave, lane);
#endif
            } else { rw_unit_prompt(P, lds, (u - 16) >> 3, (u - 16) & 7, tid, wave, lane);
#ifdef PROBE_PROMPT2
                __syncthreads(); rw_unit_prompt(P, lds, (u - 16) >> 3, (u - 16) & 7, tid, wave, lane);
#endif
            }
            __syncthreads();
        }
    } SEAM(4);
    if (IN(5)) for (int rep_ = 0; rep_ < REPS(5); ++rep_) { rw_post_sample(P, G, vcu, tid); } SEAM(5);
    if (IN(6)) for (int rep_ = 0; rep_ < REPS(6); ++rep_) {
        pg8::Gemm g{(const pg8::bf16_t*)(P.ws + WS_MIX), (const pg8::bf16_t*)(P.ws + WS_WO0), M, D, D}; pg8::StaticOrder S; S.init(M, D, G, bx);
        pg8::EpiF32 E{(float*)(P.ws + WS_Y), D};
        pg8::gemm_phase<pg8::EpiF32, pg8::StaticOrder, true, true>(lds, g, S, E);
    } SEAM(6);
    if (IN(7)) for (int rep_ = 0; rep_ < REPS(7); ++rep_) { p6_mid(P, lds, G, vcu, wave, lane, tid); } SEAM(7);
    if (IN(8)) for (int rep_ = 0; rep_ < REPS(8); ++rep_) {
        pg8::Gemm g{(const pg8::bf16_t*)(P.ws + WS_XN), (const pg8::bf16_t*)(P.ws + WS_WT1), M, N1, D}; pg8::StaticOrder S; S.init(M, N1, G, bx);
        pg8::EpiIn E{(pg8::bf16_t*)(P.ws + WS_PROJ), N1, N1, 2048, (const float*)(P.ws + WS_ROPE), P.out + OUT_CK, P.out + OUT_CV, 1024, 2048, 2048, 3072, 1024, 1024};
        pg8::gemm_phase<pg8::EpiIn, pg8::StaticOrder, true, true>(lds, g, S, E);
    } SEAM(8);
    if (IN(9)) for (int rep_ = 0; rep_ < REPS(9); ++rep_) {
        const float d1 = wave_sum(P.in[I_LQ1][lane] * P.in[I_LK1][lane]), d2 = wave_sum(P.in[I_LQ2][lane] * P.in[I_LK2][lane]);
        const float lam = expf(d1) - expf(d2) + 0.35550906759f;
        for (int u = bx; u < 768; u += G) {
            if (u < 256) attnC_unit(P, lds, true, u >> 7, (u >> 4) & 7, u & 15, lam, tid, wave, lane);
            else { const int i = u - 256; attnC_unit(P, lds, false, i >> 4, (i >> 1) & 7, i & 1, lam, tid, wave, lane); }
            __syncthreads();
        }
    } SEAM(9);
    if (IN(10)) for (int rep_ = 0; rep_ < REPS(10); ++rep_) {
        pg8::Gemm g{(const pg8::bf16_t*)(P.ws + WS_MIX), (const pg8::bf16_t*)(P.ws + WS_WO1), M, D, D}; pg8::StaticOrder S; S.init(M, D, G, bx);
        pg8::EpiF32 E{(float*)(P.ws + WS_Y), D};
        pg8::gemm_phase<pg8::EpiF32, pg8::StaticOrder, true, true>(lds, g, S, E);
    } SEAM(10);
    if (IN(11)) for (int rep_ = 0; rep_ < REPS(11); ++rep_) { p10_final(P, lds, G, vcu, wave, lane, tid); }
#undef IN
#undef SEAM
}

extern "C" void kernel_launch(void* const* d_in, const int* in_sizes, int n_in, void* d_out, int out_size, void* d_ws, size_t ws_size, hipStream_t stream) {
    static int grid = 0;
    if (grid == 0) {
        if (n_in != 32 || out_size != 33554432 || ws_size < WS_END) { fprintf(stderr, "kernel_launch: unexpected shapes (n_in %d out %d ws %zu)\n", n_in, out_size, ws_size); grid = -1; return; }
        int dev = 0, cus = 0, per_cu = 0;
        if (hipGetDevice(&dev) != hipSuccess || hipDeviceGetAttribute(&cus, hipDeviceAttributeMultiprocessorCount, dev) != hipSuccess) { grid = -1; return; }
        if (hipFuncSetAttribute((const void*)mega_fwd, hipFuncAttributeMaxDynamicSharedMemorySize, LDS_BYTES) != hipSuccess) { fprintf(stderr, "kernel_launch: hipFuncSetAttribute failed\n"); grid = -1; return; }
        if (hipOccupancyMaxActiveBlocksPerMultiprocessor(&per_cu, (const void*)mega_fwd, NWAVES * 64, LDS_BYTES) != hipSuccess || per_cu < 1) { fprintf(stderr, "kernel_launch: occupancy query says %d\n", per_cu); per_cu = 1; }
        (void)hipGetLastError();
        grid = cus;
    }
    if (grid < 0) return;
    (void)hipMemsetAsync((char*)d_ws + WS_CTL, 0, CTL_ZERO_BYTES, stream);
    Params a{};
    for (int i = 0; i < 32; ++i) a.in[i] = (const float*)d_in[i];
    a.out = (float*)d_out; a.ws = (unsigned char*)d_ws;
#ifndef MK_PER_PHASE
    a.ph_lo = 0; a.ph_hi = NPH;
    hipLaunchKernelGGL(mega_fwd, dim3(grid), dim3(NWAVES * 64), LDS_BYTES, stream, a);
#else
    for (int p = 0; p < NPH; ++p) { a.ph_lo = p; a.ph_hi = p + 1; hipLaunchKernelGGL(mega_fwd, dim3(grid), dim3(NWAVES * 64), LDS_BYTES, stream, a); }
#endif
    const hipError_t le = hipPeekAtLastError();
    if (le != hipSuccess) fprintf(stderr, "kernel_launch: launch failed: %s\n", hipGetErrorName(le));
}
```

```cpp
#include <hip/hip_runtime.h>
#include <cstdio>
#include <cstdint>
namespace pg8 {
#define PG8_LAS __attribute__((address_space(3)))
typedef unsigned short bf16_t;
typedef short bf16x8 __attribute__((ext_vector_type(8)));
typedef float f32x4 __attribute__((ext_vector_type(4)));
typedef unsigned u32x4 __attribute__((ext_vector_type(4)));
constexpr int BM = 256, BK = 64, HALF = 128, HTB = HALF * BK * 2  , STAGE_BYTES = 8 * HTB, NXCD = 8, WGM = 8;

__host__ __device__ __forceinline__ int lds_byte(int r, int c) { const int st = (r >> 4) * 2 + (c >> 5), rr = r & 15, cc = c & 31, ob = rr * 64 + cc * 2; return st * 1024 + (ob ^ (((ob >> 9) & 1) << 5)); }
__host__ __device__ __forceinline__ void stage_rc(int b, int& R, int& C) { const int st = b / 1024, sb = b % 1024, swz = sb ^ (((sb >> 9) & 1) << 5); R = (st >> 1) * 16 + swz / 64; C = (st & 1) * 32 + (swz % 64) / 2; }
__host__ __device__ __forceinline__ int perm32(int rho) { const int n = rho >> 4, i = rho & 15; return 8 * (i >> 2) + 4 * n + (i & 3); }

struct Unit { int pm, pn; };
struct Gemm { const bf16_t* A; const bf16_t* Bt; int M, N, K; };

struct StaticOrder {
    int nM, nN, nwg, G, c;
    __host__ __device__ void init(int M, int N, int G_, int c_) { nM = M / BM; nN = N / BM; nwg = nM * nN; G = G_; c = c_; }
    __host__ __device__ bool next(int i, Unit& u) const {
        const long L = (long)i * G + c; if (L >= nwg) return false;
        int wgid = (int)L; { const int q = nwg / NXCD, r = nwg % NXCD, xcd = wgid % NXCD, off = wgid / NXCD; wgid = (xcd < r ? xcd * (q + 1) : r * (q + 1) + (xcd - r) * q) + off; }
        const int nig = WGM * nN, gid = wgid / nig, fm = gid * WGM, gsz = (nM - fm) < WGM ? (nM - fm) : WGM;
        u.pm = fm + ((wgid % nig) % gsz); u.pn = (wgid % nig) / gsz; return true;
    }
    __device__ __forceinline__ void a_ready(const Unit&) const {}
    __device__ __forceinline__ void done(const Unit&) const {}
};

__device__ __forceinline__ unsigned cvt_pk_bf16(float lo, float hi) { unsigned r; asm volatile("v_cvt_pk_bf16_f32 %0, %1, %2" : "=v"(r) : "v"(lo), "v"(hi)); return r; }
typedef float f32x2 __attribute__((ext_vector_type(2)));
struct EpiF32 {
    static constexpr bool PERM = false, AFTER_DRAIN = false;
    float* C; int ldc;
    __device__ __forceinline__ void operator()(const f32x4 (&acc)[2][2][4][2], const Unit& u, int wr, int wc, int fr, int fq) const {
        const int row0 = u.pm * BM + wr * 64 + fr, col0 = u.pn * BM + wc * 32 + 4 * fq;
#pragma unroll
        for (int ai = 0; ai < 2; ++ai)
#pragma unroll
            for (int m = 0; m < 4; ++m) { float* rowp = C + (size_t)(row0 + ai * HALF + m * 16) * ldc + col0;
#pragma unroll
                for (int bj = 0; bj < 2; ++bj)
#pragma unroll
                    for (int n = 0; n < 2; ++n) *(f32x4*)(rowp + bj * HALF + n * 16) = acc[ai][bj][m][n]; }
    }
};
struct EpiIn {
    static constexpr bool PERM = true, AFTER_DRAIN = false;
    bf16_t* O; int ldc; int nvalid; int rope_cols; const float* rope;
    float* out_k; float* out_v; int ck0, ck1, cv0, cv1, cpk, cpv;
    __device__ __forceinline__ void operator()(const f32x4 (&acc)[2][2][4][2], const Unit& u, int wr, int wc, int fr, int fq) const {
#pragma unroll
        for (int bj = 0; bj < 2; ++bj) {
            const int colbase = u.pn * BM + bj * HALF;
            if (colbase >= nvalid) continue;
            const int col0 = colbase + wc * 32 + 8 * fq;
            const bool dorope = (u.pm >= 32) && (colbase < rope_cols);
            const bool isk = (u.pm < 32) && (colbase >= ck0) && (colbase < ck1);
            const bool isv = (u.pm < 32) && (colbase >= cv0) && (colbase < cv1);
#pragma unroll
            for (int ai = 0; ai < 2; ++ai)
#pragma unroll
                for (int m = 0; m < 4; ++m) {
                    const int row = u.pm * BM + ai * HALF + wr * 64 + m * 16 + fr;
                    f32x4 v0 = acc[ai][bj][m][0], v1 = acc[ai][bj][m][1];
                    if (dorope) {
                        const int t = (row - 8192) & 2047; const int pos = (wc & 1) ? (t & 63) : (t >> 6);
                        const float* cs = rope + (pos * 16 + 8 * (fq & 1)) * 2;
                        const float sg = (fq < 2) ? -1.f : 1.f;
                        f32x4 p0, p1;
#pragma unroll
                        for (int i = 0; i < 4; ++i) { p0[i] = __shfl_xor(v0[i], 32); p1[i] = __shfl_xor(v1[i], 32); }
                        const f32x4 c0 = *(const f32x4*)(cs), c1 = *(const f32x4*)(cs + 4), c2 = *(const f32x4*)(cs + 8), c3 = *(const f32x4*)(cs + 12);
                        v0[0] = v0[0] * c0[0] + sg * p0[0] * c0[1]; v0[1] = v0[1] * c0[2] + sg * p0[1] * c0[3];
                        v0[2] = v0[2] * c1[0] + sg * p0[2] * c1[1]; v0[3] = v0[3] * c1[2] + sg * p0[3] * c1[3];
                        v1[0] = v1[0] * c2[0] + sg * p1[0] * c2[1]; v1[1] = v1[1] * c2[2] + sg * p1[1] * c2[3];
                        v1[2] = v1[2] * c3[0] + sg * p1[2] * c3[1]; v1[3] = v1[3] * c3[2] + sg * p1[3] * c3[3];
                    }
                    u32x4 w; w.x = cvt_pk_bf16(v0[0], v0[1]); w.y = cvt_pk_bf16(v0[2], v0[3]); w.z = cvt_pk_bf16(v1[0], v1[1]); w.w = cvt_pk_bf16(v1[2], v1[3]);
                    *(u32x4*)(O + (size_t)row * ldc + col0) = w;
                    if (isk) { float* p = out_k + (size_t)row * cpk + (col0 - ck0); *(f32x4*)p = v0; *(f32x4*)(p + 4) = v1; }
                    if (isv) { float* p = out_v + (size_t)row * cpv + (col0 - cv0); *(f32x4*)p = v0; *(f32x4*)(p + 4) = v1; }
                }
        }
    }
};
template <class Epi, class Sched, bool ALIGN_EPI = false, bool SP2 = false>
__device__ __forceinline__ void gemm_phase(PG8_LAS unsigned char* lds, const Gemm g, const Sched& S, const Epi& E) {
    const int tid = threadIdx.x, wid = __builtin_amdgcn_readfirstlane(tid >> 6), lane = tid & 63, wr = wid >> 2, wc = wid & 3, fr = lane & 15, fq = lane >> 4;
    const int K = g.K, nt = K / BK;
    unsigned voffA[2], voffB[2];
#pragma unroll
    for (int i = 0; i < 2; ++i) { int R, C; stage_rc(tid * 16 + i * 8192, R, C); const int Rb = Epi::PERM ? ((R & ~31) + perm32(R & 31)) : R;
        voffA[i] = (unsigned)(R * K + C) * 2u; voffB[i] = (unsigned)(Rb * K + C) * 2u; }
    const size_t kstep = (size_t)(BK * 2);
    const size_t hstep = (size_t)HALF * K * 2;
    const size_t tstep = 2 * hstep;
    const unsigned ldsw = (unsigned)wid * 1024u;
    const int aoff = lds_byte(wr * 64 + fr, fq * 8), boff = lds_byte(wc * 32 + fr, fq * 8);
#define PG8_SA(b, h) (((b) * 2 + (h)) * HTB)
#define PG8_SB(b, h) ((4 + (b) * 2 + (h)) * HTB)
#define PG8_STAGE(bufoff, gbase, voff) do { _Pragma("unroll") for (int _i = 0; _i < 2; ++_i) \
        __builtin_amdgcn_global_load_lds((const unsigned*)((const char*)(gbase) + (voff)[_i]), (PG8_LAS unsigned*)(lds + (bufoff) + ldsw + _i * 8192), 16, 0, 0); } while (0)
#define PG8_LDA(dst, b, h) do { _Pragma("unroll") for (int m = 0; m < 4; ++m) _Pragma("unroll") for (int k = 0; k < 2; ++k) dst[m][k] = *(const PG8_LAS bf16x8*)(lds + PG8_SA(b, h) + aoff + m * 2048 + k * 1024); } while (0)
#define PG8_LDB(dst, b, h) do { _Pragma("unroll") for (int n = 0; n < 2; ++n) _Pragma("unroll") for (int k = 0; k < 2; ++k) dst[n][k] = *(const PG8_LAS bf16x8*)(lds + PG8_SB(b, h) + boff + n * 2048 + k * 1024); } while (0)
#define PG8_MMA(ai, bj, At, Bt) do { __builtin_amdgcn_s_setprio(1); _Pragma("unroll") for (int m = 0; m < 4; ++m) _Pragma("unroll") for (int n = 0; n < 2; ++n) _Pragma("unroll") for (int k = 0; k < 2; ++k) \
        acc[ai][bj][m][n] = __builtin_amdgcn_mfma_f32_16x16x32_bf16(Bt[n][k], At[m][k], acc[ai][bj][m][n], 0, 0, 0); __builtin_amdgcn_s_setprio(0); } while (0)
#define PG8_WAIT_V(n) asm volatile("s_waitcnt vmcnt(" #n ")" ::: "memory")
#define PG8_WAIT_L(n) asm volatile("s_waitcnt lgkmcnt(" #n ")" ::: "memory")
#define PG8_BAR __builtin_amdgcn_s_barrier()
#define PG8_SCHED __builtin_amdgcn_sched_barrier(0)
    Unit cur, nxt; int ui = 0;
    if (!S.next(0, cur)) return;
    f32x4 acc[2][2][4][2];
#pragma unroll
    for (int a = 0; a < 2; ++a)
#pragma unroll
        for (int b = 0; b < 2; ++b)
#pragma unroll
            for (int m = 0; m < 4; ++m)
#pragma unroll
                for (int n = 0; n < 2; ++n) acc[a][b][m][n] = (f32x4){0.f, 0.f, 0.f, 0.f};
    bf16x8 At[4][2], B0[2][2], B1[2][2];
    const char* cA = (const char*)g.A + (size_t)cur.pm * tstep; const char* cB = (const char*)g.Bt + (size_t)cur.pn * tstep;
    S.a_ready(cur);
    if constexpr (SP2) {
        PG8_STAGE(PG8_SB(0, 0), cB, voffB); PG8_STAGE(PG8_SB(0, 1), cB + hstep, voffB); PG8_STAGE(PG8_SA(0, 0), cA, voffA); PG8_STAGE(PG8_SA(0, 1), cA + hstep, voffA);
        if (wr == 1) PG8_BAR;
        PG8_WAIT_V(2); PG8_BAR;
        PG8_STAGE(PG8_SB(1, 0), cB + kstep, voffB); PG8_STAGE(PG8_SA(1, 0), cA + kstep, voffA); PG8_STAGE(PG8_SB(1, 1), cB + hstep + kstep, voffB);
        PG8_WAIT_V(6); PG8_BAR;
    } else {
        PG8_STAGE(PG8_SB(0, 0), cB, voffB); PG8_STAGE(PG8_SA(0, 0), cA, voffA); PG8_STAGE(PG8_SB(0, 1), cB + hstep, voffB); PG8_STAGE(PG8_SA(0, 1), cA + hstep, voffA);
        if (wr == 1) PG8_BAR;
        PG8_WAIT_V(4); PG8_BAR;
        PG8_STAGE(PG8_SB(1, 0), cB + kstep, voffB); PG8_STAGE(PG8_SA(1, 0), cA + kstep, voffA); PG8_STAGE(PG8_SB(1, 1), cB + hstep + kstep, voffB);
        PG8_WAIT_V(6); PG8_BAR;
    }
    for (;;) {
        const bool has_next = S.next(ui + 1, nxt);
        const char* nA = has_next ? (const char*)g.A + (size_t)nxt.pm * tstep : cA; const char* nB = has_next ? (const char*)g.Bt + (size_t)nxt.pn * tstep : cB;
        for (int t = 0; t < nt; t += 2) {
            const bool last = (t == nt - 2);
            const char* a1 = cA + (size_t)(t + 1) * kstep;
            const char* a2 = last ? nA : cA + (size_t)(t + 2) * kstep; const char* b2 = last ? nB : cB + (size_t)(t + 2) * kstep;
            const char* a3 = a2 + kstep; const char* b3 = b2 + kstep;
            if (last && has_next) S.a_ready(nxt);
            if constexpr (SP2) {
            PG8_LDB(B0, 0, 0); PG8_LDB(B1, 0, 1); PG8_SCHED; PG8_LDA(At, 0, 0); PG8_STAGE(PG8_SA(1, 1), a1 + hstep, voffA);
            PG8_WAIT_V(8); PG8_WAIT_L(0); PG8_BAR; PG8_MMA(0, 0, At, B0); PG8_MMA(0, 1, At, B1); PG8_BAR; PG8_SCHED;
            PG8_LDA(At, 0, 1); PG8_STAGE(PG8_SB(0, 0), b2, voffB); PG8_STAGE(PG8_SB(0, 1), b2 + hstep, voffB); PG8_STAGE(PG8_SA(0, 0), a2, voffA);
            PG8_WAIT_V(8); PG8_WAIT_L(0); PG8_BAR; PG8_MMA(1, 0, At, B0); PG8_MMA(1, 1, At, B1); PG8_BAR; PG8_SCHED;
            PG8_LDB(B0, 1, 0); PG8_LDB(B1, 1, 1); PG8_SCHED; PG8_LDA(At, 1, 0); PG8_STAGE(PG8_SA(0, 1), a2 + hstep, voffA);
            PG8_WAIT_V(8); PG8_WAIT_L(0); PG8_BAR; PG8_MMA(0, 0, At, B0); PG8_MMA(0, 1, At, B1); PG8_BAR; PG8_SCHED;
            PG8_LDA(At, 1, 1); PG8_STAGE(PG8_SB(1, 0), b3, voffB); PG8_STAGE(PG8_SB(1, 1), b3 + hstep, voffB); PG8_STAGE(PG8_SA(1, 0), a3, voffA);
            PG8_WAIT_V(8); PG8_WAIT_L(0); PG8_BAR; PG8_MMA(1, 0, At, B0); PG8_MMA(1, 1, At, B1); PG8_BAR; PG8_SCHED;
            } else {
            PG8_LDB(B0, 0, 0); PG8_SCHED; PG8_LDA(At, 0, 0); PG8_STAGE(PG8_SA(1, 1), a1 + hstep, voffA);
            PG8_WAIT_L(8); PG8_BAR; PG8_WAIT_L(0); PG8_MMA(0, 0, At, B0); PG8_BAR; PG8_SCHED;
            PG8_LDB(B1, 0, 1); PG8_STAGE(PG8_SB(0, 0), b2, voffB);
            PG8_BAR; PG8_WAIT_L(0); PG8_MMA(0, 1, At, B1); PG8_BAR;
            PG8_LDA(At, 0, 1); PG8_STAGE(PG8_SA(0, 0), a2, voffA);
            PG8_BAR; PG8_WAIT_L(0); PG8_MMA(1, 0, At, B0); PG8_BAR; PG8_SCHED;
            PG8_STAGE(PG8_SB(0, 1), b2 + hstep, voffB);
            PG8_WAIT_V(6); PG8_BAR; PG8_MMA(1, 1, At, B1); PG8_BAR;
            PG8_LDB(B0, 1, 0); PG8_SCHED; PG8_LDA(At, 1, 0); PG8_STAGE(PG8_SA(0, 1), a2 + hstep, voffA);
            PG8_WAIT_L(8); PG8_BAR; PG8_WAIT_L(0); PG8_MMA(0, 0, At, B0); PG8_BAR; PG8_SCHED;
            PG8_LDB(B1, 1, 1); PG8_STAGE(PG8_SB(1, 0), b3, voffB);
            PG8_BAR; PG8_WAIT_L(0); PG8_MMA(0, 1, At, B1); PG8_BAR;
            PG8_LDA(At, 1, 1); PG8_STAGE(PG8_SA(1, 0), a3, voffA);
            PG8_BAR; PG8_WAIT_L(0); PG8_MMA(1, 0, At, B0); PG8_BAR; PG8_SCHED;
            PG8_STAGE(PG8_SB(1, 1), b3 + hstep, voffB);
            PG8_WAIT_V(6); PG8_BAR; PG8_MMA(1, 1, At, B1); PG8_BAR;
            }
        }
        if constexpr (ALIGN_EPI) { if (wr == 0) PG8_BAR; }
        if constexpr (!Epi::AFTER_DRAIN) { E(acc, cur, wr, wc, fr, fq); S.done(cur); }
        if (!has_next) break;
#pragma unroll
        for (int a = 0; a < 2; ++a)
#pragma unroll
            for (int b = 0; b < 2; ++b)
#pragma unroll
                for (int m = 0; m < 4; ++m)
#pragma unroll
                    for (int n = 0; n < 2; ++n) acc[a][b][m][n] = (f32x4){0.f, 0.f, 0.f, 0.f};
        cur = nxt; cA = nA; cB = nB; ++ui;
        if constexpr (ALIGN_EPI) { if (wr == 1) PG8_BAR; }
    }
    PG8_WAIT_V(0);
    if constexpr (!ALIGN_EPI) { if (wr == 0) PG8_BAR; }
    PG8_BAR;
    if constexpr (Epi::AFTER_DRAIN) { E.fused(acc, cur, wr, wc, fr, fq, lds, wid, lane); S.done(cur); }
#undef PG8_SA
#undef PG8_SB
#undef PG8_STAGE
#undef PG8_LDA
#undef PG8_LDB
#undef PG8_MMA
#undef PG8_WAIT_V
#undef PG8_WAIT_L
#undef PG8_BAR
#undef PG8_SCHED
}
}
#define GAS __attribute__((address_space(1)))
#define LAS __attribute__((address_space(3)))
typedef unsigned short bf16;
typedef unsigned v4u __attribute__((ext_vector_type(4)));
typedef float f32x4 __attribute__((ext_vector_type(4)));
typedef short bf16x8 __attribute__((ext_vector_type(8)));
typedef GAS unsigned gu32;
typedef GAS unsigned long long gu64;
#define RLX_AGENT __ATOMIC_RELAXED, __HIP_MEMORY_SCOPE_AGENT
#define LDS_WAIT() asm volatile("s_waitcnt lgkmcnt(0)" ::: "memory")
#define VM_WAIT() asm volatile("s_waitcnt vmcnt(0)" ::: "memory")
__device__ __forceinline__ unsigned long long rt() { return __builtin_amdgcn_s_memrealtime(); }
__device__ __forceinline__ unsigned f2bf(float f) { unsigned u = __builtin_bit_cast(unsigned, f); return (u + 0x7fffu + ((u >> 16) & 1u)) >> 16; }
__device__ __forceinline__ unsigned pk2(float lo, float hi) { return f2bf(lo) | (f2bf(hi) << 16); }

#define XB_TMO      128
#define XB_XCNT(j)  (256  + 64 * (j))
#define XB_XSUB(j)  (1280 + 64 * (j))
#define XB_XGEN(j)  (2304 + 64 * (j))
#define XB_TOP      3328
#define XB_TOPGEN   3392
#define XCD_BAR_WORDS 3456
#define XB_SPIN_CAP (1u << 18)

__device__ __forceinline__ unsigned xb_ld(unsigned* p)              { return __hip_atomic_load(p, __ATOMIC_RELAXED, __HIP_MEMORY_SCOPE_AGENT); }
__device__ __forceinline__ unsigned xb_add(unsigned* p, unsigned v) { return __hip_atomic_fetch_add(p, v, __ATOMIC_RELAXED, __HIP_MEMORY_SCOPE_AGENT); }
__device__ __forceinline__ unsigned xb_xcc_id() { return (unsigned)__builtin_amdgcn_s_getreg((3 << 11) | 20) & 0xFu; }
#define XB_SPIN(cond, bar) do { unsigned _sp = 0; while (cond) { __builtin_amdgcn_s_sleep(1); \
    if ((++_sp & 255u) == 0u) { if (xb_ld(&(bar)[XB_TMO])) break; if (_sp > XB_SPIN_CAP) { atomicAdd(&(bar)[XB_TMO], 1u); break; } } } } while (0)

struct XcdBarrier {
    unsigned* bar; unsigned x;
    volatile LAS unsigned* st;
};

__device__ __forceinline__ XcdBarrier xcd_barrier_post(unsigned* bar, volatile LAS unsigned* st) {
    XcdBarrier b; b.bar = bar; b.x = xb_xcc_id(); b.st = st;
    if (threadIdx.x == 0) (void)xb_add(&bar[XB_XCNT(b.x)], 1u);
    return b;
}
__device__ __forceinline__ void xcd_barrier_complete(unsigned* bar, unsigned x, unsigned& nloc, unsigned& nx) {
    const unsigned G = gridDim.x * gridDim.y * gridDim.z;
    unsigned sum, cnt, mine, sp = 0u;
    for (;;) {
        sum = 0u; cnt = 0u; mine = 0u;
#pragma unroll
        for (unsigned j = 0; j < 16; ++j) { const unsigned c = xb_ld(&bar[XB_XCNT(j)]); sum += c; cnt += (c > 0u) ? 1u : 0u; mine = (j == x) ? c : mine; }
        if (sum == G) break;
        __builtin_amdgcn_s_sleep(1);
        if ((++sp & 255u) == 0u) { if (xb_ld(&bar[XB_TMO])) break; if (sp > XB_SPIN_CAP) { atomicAdd(&bar[XB_TMO], 1u); break; } }
    }
    nloc = mine > 0u ? mine : 1u; nx = cnt > 0u ? cnt : 1u;
}

__device__ __forceinline__ void xcd_barrier(const XcdBarrier& b) {
    asm volatile("s_waitcnt vmcnt(0)" ::: "memory");
    __syncthreads();
    if (threadIdx.x == 0) {
        unsigned* bar = b.bar;
        __builtin_amdgcn_s_waitcnt(0);
        unsigned nloc = b.st[0], nx = b.st[1];
        if (nloc == 0u) { xcd_barrier_complete(bar, b.x, nloc, nx); b.st[0] = nloc; b.st[1] = nx; }
        const unsigned old = xb_add(&bar[XB_XSUB(b.x)], 1u);
        const unsigned gen = old / nloc;
        if (old + 1u == (gen + 1u) * nloc) {
            __builtin_amdgcn_fence(__ATOMIC_RELEASE, "agent");
            asm volatile("s_waitcnt vmcnt(0)" ::: "memory");
            const unsigned og = xb_add(&bar[XB_TOP], 1u);
            const unsigned tg = og / nx;
            if (og + 1u == (tg + 1u) * nx) xb_add(&bar[XB_TOPGEN], 1u);
            else XB_SPIN(xb_ld(&bar[XB_TOPGEN]) == tg, bar);
            __builtin_amdgcn_fence(__ATOMIC_ACQUIRE, "agent");
            xb_add(&bar[XB_XGEN(b.x)], 1u);
            asm volatile("s_waitcnt vmcnt(0)" ::: "memory");
        } else {
            XB_SPIN(xb_ld(&bar[XB_XGEN(b.x)]) == gen, bar);
            __builtin_amdgcn_fence(__ATOMIC_ACQUIRE, "agent");
            asm volatile("s_waitcnt vmcnt(0)" ::: "memory");
        }
    }
    __syncthreads();
}
constexpr int NWAVES = 8;
constexpr int D = 1024, MP = 8192, MS = 4096, M = MP + MS;
constexpr int N0 = 3456, N0P = 3584, N1 = 4096;
constexpr float NORM_EPS = 1e-6f;
constexpr size_t OUT_Y = 0, OUT_AK = 12582912, OUT_AV = 13631488, OUT_ST = 14680064, OUT_CK = 16777216, OUT_CV = 25165824;
constexpr size_t MiB = 1u << 20;
constexpr size_t WS_CTL = 0, CTL_ZERO_BYTES = 64 * 1024;
constexpr size_t WS_WT0 = 2 * MiB, WS_WO0 = 9 * MiB, WS_WT1 = 11 * MiB, WS_WO1 = 19 * MiB;
constexpr size_t WS_MODP = 21 * MiB, WS_ROPE = 22 * MiB, WS_LORA = 22 * MiB + 65536;
constexpr size_t WS_CAK = 23 * MiB, WS_CAV = WS_CAK + 131072, WS_CCK = WS_CAV + 131072, WS_CCV = WS_CCK + MiB;
constexpr size_t WS_BONUS = 26 * MiB, WS_XN = 27 * MiB, WS_MIX = 51 * MiB, WS_PROJ = 75 * MiB, WS_Y = 171 * MiB, WS_REC = 171 * MiB, WS_YF = 27 * MiB, WS_YB = 225 * MiB, WS_END = 249 * MiB;
constexpr int CW_BAR = 4096;
constexpr int RING_BYTES = 131072, LDSCTL_OFF = RING_BYTES, MISC_OFF = LDSCTL_OFF + 320, LDS_BYTES = 147456;

struct Params { const float* in[32]; float* out; unsigned char* ws; int ph_lo, ph_hi; };
enum { I_XP = 0, I_XS, I_CAK, I_CAV, I_ST, I_CCK, I_CCV, I_C, I_CCTX, I_ADAW, I_ADAB, I_NPRE, I_NPOST, I_WOUT, I_EWIN, I_SINK, I_MU, I_W0, I_W2, I_A0, I_A2, I_KK, I_KA, I_RK,
       I_LNW, I_LNB, I_OWIN, I_LQ1, I_LK1, I_LQ2, I_LK2, I_SUBLN };

__device__ __forceinline__ float wave_sum(float v) {
#pragma unroll
    for (int o = 1; o < 64; o <<= 1) v += __shfl_xor(v, o);
    return v;
}
__device__ __forceinline__ float bf2f(bf16 v) { return __builtin_bit_cast(float, (unsigned)v << 16); }
__device__ __forceinline__ float silu_f(float x) { return x * __builtin_amdgcn_rcpf(1.f + __expf(-x)); }
__device__ __forceinline__ const float* xrow(const Params& P, int r) { return r < MP ? P.in[I_XP] + (size_t)r * D : P.in[I_XS] + (size_t)(r - MP) * D; }
__device__ __forceinline__ int modidx(int r) { return r < MP ? 0 : 1 + ((r - MP) >> 11); }

__device__ __forceinline__ void p0_transpose_item(const float* W, int K, int N, bf16* WT, LAS float* scr, int item, int lane) {
    const int nblk = N / 32, kb = item / nblk, nb = item % nblk, k0 = 64 * kb, n0 = 32 * nb;
#pragma unroll 8
    for (int i = 0; i < 32; ++i) { const int kk = 2 * i + (lane >> 5); scr[kk * 33 + (lane & 31)] = W[(size_t)(k0 + kk) * N + n0 + (lane & 31)]; }
    LDS_WAIT(); asm volatile("" ::: "memory");
    const int c = lane & 7;
#pragma unroll
    for (int j = 0; j < 4; ++j) { const int n = (lane >> 3) + 8 * j; const LAS float* s = scr + (8 * c) * 33 + n;
        v4u o; o.x = pk2(s[0 * 33], s[1 * 33]); o.y = pk2(s[2 * 33], s[3 * 33]); o.z = pk2(s[4 * 33], s[5 * 33]); o.w = pk2(s[6 * 33], s[7 * 33]);
        *(GAS v4u*)(WT + (size_t)(n0 + n) * K + k0 + 8 * c) = o; }
    LDS_WAIT(); asm volatile("" ::: "memory");
}
__device__ __forceinline__ float mod_val(const Params& P, int l, int j, int n) {
    const float* mp = (const float*)(P.ws + WS_MODP);
    float s = P.in[I_ADAB][l * 3072 + n];
#pragma unroll
    for (int kc = 0; kc < 8; ++kc) s += mp[((l * 8 + kc) * 3 + j) * 3072 + n];
    return s;
}

__device__ __forceinline__ void p0_prologue(const Params& P, LAS unsigned char* lds, int G, int vcu, int wave, int lane, int tid) {
    LAS float* scr = (LAS float*)(lds + wave * 16384);
    const int gw = vcu * NWAVES + wave, NGW = G * NWAVES;
    constexpr int I_T0 = 16 * (N0 / 32), I_TO = 16 * 32, I_T1 = 16 * (N1 / 32), I_MOD = 2 * 8 * 48;
    constexpr int NITEMS = I_T0 + 2 * I_TO + I_T1 + I_MOD;
    for (int it = gw; it < NITEMS; it += NGW) {
        int r = it;
        if (r < I_MOD) {
            const int l = r / 384, rem = r % 384, kc = rem / 48, nb = rem % 48, n = nb * 64 + lane, k0 = kc * 128;
            const float* W = P.in[I_ADAW] + ((size_t)l * 1024 + k0) * 3072 + n;
            const float* c0p = P.in[I_CCTX] + k0; const float* c1p = P.in[I_C] + k0; const float* c2p = P.in[I_C] + 1024 + k0;
            float a0 = 0.f, a1 = 0.f, a2 = 0.f;
#pragma unroll 8
            for (int kk = 0; kk < 128; ++kk) { const float w = W[(size_t)kk * 3072];
                a0 += silu_f(c0p[kk]) * w; a1 += silu_f(c1p[kk]) * w; a2 += silu_f(c2p[kk]) * w; }
            float* mp = (float*)(P.ws + WS_MODP) + (size_t)((l * 8 + kc) * 3) * 3072 + n;
            mp[0] = a0; mp[3072] = a1; mp[6144] = a2;
            continue; }
        r -= I_MOD;
        if (r < I_T0) { p0_transpose_item(P.in[I_EWIN], D, N0, (bf16*)(P.ws + WS_WT0), scr, r, lane); continue; } r -= I_T0;
        if (r < I_TO) { p0_transpose_item(P.in[I_WOUT], D, D, (bf16*)(P.ws + WS_WO0), scr, r, lane); continue; } r -= I_TO;
        if (r < I_TO) { p0_transpose_item(P.in[I_WOUT] + (size_t)D * D, D, D, (bf16*)(P.ws + WS_WO1), scr, r, lane); continue; } r -= I_TO;
        p0_transpose_item(P.in[I_OWIN], D, N1, (bf16*)(P.ws + WS_WT1), scr, r, lane);
    }
    const int gt = vcu * 512 + tid, NT = G * 512;
    { unsigned* z = (unsigned*)(P.ws + WS_WT0 + (size_t)N0 * D * 2); for (int i = gt; i < 128 * D / 2; i += NT) z[i] = 0u; }
    { const float* s0 = P.in[I_CAK]; const float* s1 = P.in[I_CAV]; const float* s2 = P.in[I_CCK]; const float* s3 = P.in[I_CCV];
      unsigned* d0 = (unsigned*)(P.ws + WS_CAK); unsigned* d1 = (unsigned*)(P.ws + WS_CAV); unsigned* d2 = (unsigned*)(P.ws + WS_CCK); unsigned* d3 = (unsigned*)(P.ws + WS_CCV);
      for (int i = gt; i < 32768; i += NT) { d0[i] = pk2(s0[2 * i], s0[2 * i + 1]); d1[i] = pk2(s1[2 * i], s1[2 * i + 1]); }
      for (int i = gt; i < 262144; i += NT) { d2[i] = pk2(s2[2 * i], s2[2 * i + 1]); d3[i] = pk2(s3[2 * i], s3[2 * i + 1]); } }
    { unsigned short* wt = (unsigned short*)(P.ws + WS_LORA); const float* w2 = P.in[I_W2]; const float* a2 = P.in[I_A2];
      for (int i = gt; i < 65536; i += NT) { const int l = i & 63, cc = (i >> 6) & 63, hh = (i >> 12) & 7, z = i >> 15; const size_t si = (size_t)(z * 64 + l) * 512 + hh * 64 + cc;
        wt[i] = (unsigned short)f2bf(w2[si]); wt[65536 + i] = (unsigned short)f2bf(a2[si]); } }
    { float* rt_ = (float*)(P.ws + WS_ROPE); for (int i = gt; i < 1024; i += NT) { const int pos = i >> 4, f = i & 15;
        const float inv = 1.0f / powf(10000.0f, (float)f / 16.0f); const float ang = (float)pos * inv; float sn, cs; sincosf(ang, &sn, &cs); rt_[2 * i] = cs; rt_[2 * i + 1] = sn; } }
}

__device__ __forceinline__ void p1_hprep(const Params& P, LAS unsigned char* lds, int G, int vcu, int wave, int lane, int tid) {
    LAS float* gs = (LAS float*)lds; LAS float* sh = gs + 3 * 1024;
    for (int i = tid; i < 3 * 1024; i += 512) { const int j = i >> 10, k = i & 1023;
        gs[i] = P.in[I_NPRE][k] * (1.f + mod_val(P, 0, j, 1024 + k)); sh[i] = mod_val(P, 0, j, k); }
    __syncthreads();
    const int gw = vcu * NWAVES + wave, NGW = G * NWAVES;
    bf16* XN = (bf16*)(P.ws + WS_XN);
    for (int r = gw; r < M; r += NGW) {
        const f32x4* xr = (const f32x4*)xrow(P, r) + lane; const int j = modidx(r);
        f32x4 v[4]; float s = 0.f;
#pragma unroll
        for (int q = 0; q < 4; ++q) { v[q] = xr[64 * q]; s += (v[q].x * v[q].x + v[q].y * v[q].y) + (v[q].z * v[q].z + v[q].w * v[q].w); }
        const float rinv = 1.f / sqrtf(wave_sum(s) * (1.f / D) + NORM_EPS);
        unsigned long long* o8 = (unsigned long long*)(XN + (size_t)r * D) + lane;
#pragma unroll
        for (int q = 0; q < 4; ++q) { const int k = 256 * q + 4 * lane; const LAS float* g = gs + j * 1024 + k; const LAS float* b = sh + j * 1024 + k;
            const float o0 = v[q].x * rinv * g[0] + b[0], o1 = v[q].y * rinv * g[1] + b[1], o2 = v[q].z * rinv * g[2] + b[2], o3 = v[q].w * rinv * g[3] + b[3];
            o8[64 * q] = (unsigned long long)pk2(o0, o1) | ((unsigned long long)pk2(o2, o3) << 32); }
    }
    __syncthreads();
}
namespace att {
using bf16x8 = __attribute__((ext_vector_type(8))) short;
using s16x4  = __attribute__((ext_vector_type(4))) short;
using f32x16 = __attribute__((ext_vector_type(16))) float;
using u32x4  = __attribute__((ext_vector_type(4))) unsigned;
constexpr float SCALE = 0.125f, CSC = 0.125f * 1.4426950408889634f, THR = 8.f;
#define ATT_SBAR() __builtin_amdgcn_sched_barrier(0)
__device__ __forceinline__ int crow(int r, int hi) { return (r & 3) + 8 * (r >> 2) + 4 * hi; }
__device__ __forceinline__ unsigned cvtpk(float lo, float hi) { unsigned r; asm volatile("v_cvt_pk_bf16_f32 %0, %1, %2" : "=v"(r) : "v"(lo), "v"(hi)); return r; }
__device__ __forceinline__ void partialSM(f32x16& p0, f32x16& p1, float& m_reg, float& alpha) {
  float pmax = p0[0];
#pragma unroll
  for (int r = 1; r < 16; ++r) pmax = fmaxf(pmax, p0[r]);
#pragma unroll
  for (int r = 0; r < 16; ++r) pmax = fmaxf(pmax, p1[r]);
  { auto rr = __builtin_amdgcn_permlane32_swap(__float_as_uint(pmax), __float_as_uint(pmax), false, false);
    pmax = fmaxf(__uint_as_float(rr[0]), __uint_as_float(rr[1])); }
  float mn;
  if (__builtin_expect(__all(pmax - m_reg <= THR / SCALE), 1)) { mn = m_reg; alpha = 1.f; }
  else { mn = fmaxf(m_reg, pmax); alpha = __builtin_amdgcn_exp2f((m_reg - mn) * CSC); m_reg = mn; }
  const float mnC = -mn * CSC;
#pragma unroll
  for (int r = 0; r < 16; ++r) p0[r] = fmaf(p0[r], CSC, mnC);
#pragma unroll
  for (int r = 0; r < 16; ++r) p1[r] = fmaf(p1[r], CSC, mnC);
#pragma unroll
  for (int r = 0; r < 16; ++r) p0[r] = __builtin_amdgcn_exp2f(p0[r]);
}
__device__ __forceinline__ void finishSM(f32x16& p0, f32x16& p1, float alpha, float& l_reg, bf16x8& pa0, bf16x8& pa1, bf16x8& pa2, bf16x8& pa3) {
#pragma unroll
  for (int r = 0; r < 16; ++r) p1[r] = __builtin_amdgcn_exp2f(p1[r]);
  float ps = 0;
#pragma unroll
  for (int r = 0; r < 16; ++r) ps += p0[r];
#pragma unroll
  for (int r = 0; r < 16; ++r) ps += p1[r];
  { auto rr = __builtin_amdgcn_permlane32_swap(__float_as_uint(ps), __float_as_uint(ps), false, false);
    ps = __uint_as_float(rr[0]) + __uint_as_float(rr[1]); }
  l_reg = l_reg * alpha + ps;
#define PK4(P, BASE, OUT) do { unsigned a0 = cvtpk(P[BASE + 0], P[BASE + 1]), a1 = cvtpk(P[BASE + 2], P[BASE + 3]);   \
    unsigned b0 = cvtpk(P[BASE + 4], P[BASE + 5]), b1 = cvtpk(P[BASE + 6], P[BASE + 7]);                              \
    auto r0 = __builtin_amdgcn_permlane32_swap(a0, b0, false, false); auto r1 = __builtin_amdgcn_permlane32_swap(a1, b1, false, false); \
    u32x4 w = {r0[0], r1[0], r0[1], r1[1]}; OUT = *reinterpret_cast<bf16x8*>(&w); } while (0)
  PK4(p0, 0, pa0); PK4(p0, 8, pa1); PK4(p1, 0, pa2); PK4(p1, 8, pa3);
#undef PK4
}
template <int KW> __device__ __forceinline__ int kswz(int row, int colB) { return row * (KW * 2) + (colB ^ ((row & 7) << 4)); }
template <int KW> __device__ __forceinline__ void qkt(f32x16& p0, f32x16& p1, const LAS unsigned char* Ks, int kcolB, const bf16x8* qr, int r32, int hi) {
  p0 = f32x16{}; p1 = f32x16{};
#pragma unroll
  for (int d0 = 0; d0 < 4; ++d0) { const int cb = kcolB + (d0 * 16 + hi * 8) * 2;
    const bf16x8 b0 = *(const LAS bf16x8*)(Ks + kswz<KW>(r32, cb));
    const bf16x8 b1 = *(const LAS bf16x8*)(Ks + kswz<KW>(32 + r32, cb));
    p0 = __builtin_amdgcn_mfma_f32_32x32x16_bf16(b0, qr[d0], p0, 0, 0, 0);
    p1 = __builtin_amdgcn_mfma_f32_32x32x16_bf16(b1, qr[d0], p1, 0, 0, 0); }
}
template <int NCB> __device__ __forceinline__ int v_st(int k, int c) { const int kk = (k & ~0xC) | ((k & 4) << 1) | ((k & 8) >> 1); return ((kk >> 3) * NCB + (c >> 5)) * 512 + ((kk & 7) * 32 + (c & 31)) * 2; }
__device__ __forceinline__ int v_rd_base(int lane) { return ((lane & 3) << 3) | (((lane >> 2) & 3) << 6) | (((lane >> 4) & 1) << 5) | (((lane >> 5) & 1) << 8); }
template <int NCB> constexpr int v_rd_off(int d0, int ks, int half) { return d0 * 512 + ks * (2 * NCB * 512) + half * (NCB * 512); }
template <int OFF> __device__ __forceinline__ s16x4 tr_read(int vb) { s16x4 r; asm volatile("ds_read_b64_tr_b16 %0, %1 offset:%2" : "=&v"(r) : "v"(vb), "i"(OFF) : "memory"); return r; }
template <int NCB, int D0> __device__ __forceinline__ void pv_one(f32x16& od, int vb, bf16x8 pa0, bf16x8 pa1, bf16x8 pa2, bf16x8 pa3) {
  const s16x4 l0 = tr_read<v_rd_off<NCB>(D0, 0, 0)>(vb), h0 = tr_read<v_rd_off<NCB>(D0, 0, 1)>(vb), l1 = tr_read<v_rd_off<NCB>(D0, 1, 0)>(vb), h1 = tr_read<v_rd_off<NCB>(D0, 1, 1)>(vb);
  const s16x4 l2 = tr_read<v_rd_off<NCB>(D0, 2, 0)>(vb), h2 = tr_read<v_rd_off<NCB>(D0, 2, 1)>(vb), l3 = tr_read<v_rd_off<NCB>(D0, 3, 0)>(vb), h3 = tr_read<v_rd_off<NCB>(D0, 3, 1)>(vb);
  asm volatile("s_waitcnt lgkmcnt(0)" ::: "memory"); ATT_SBAR();
#define PK(L, H) (bf16x8){L[0], L[1], L[2], L[3], H[0], H[1], H[2], H[3]}
  od = __builtin_amdgcn_mfma_f32_32x32x16_bf16(pa0, PK(l0, h0), od, 0, 0, 0);
  od = __builtin_amdgcn_mfma_f32_32x32x16_bf16(pa1, PK(l1, h1), od, 0, 0, 0);
  od = __builtin_amdgcn_mfma_f32_32x32x16_bf16(pa2, PK(l2, h2), od, 0, 0, 0);
  od = __builtin_amdgcn_mfma_f32_32x32x16_bf16(pa3, PK(l3, h3), od, 0, 0, 0);
#undef PK
}
struct Src { const bf16* kc; const bf16* vc; int cp; const bf16* kl; const bf16* vl; int lp; int nctx; int nt; int lat0; int q0; bool mask; };
constexpr int L_K = 0, L_V = 16384, L_WS = 32768, L_CMB = 65536;

template <int KW, int DV, bool ZS>
__device__ __forceinline__ void attn_unit(LAS unsigned char* lds, const bf16* Qrow0  , int qpitch, const Src& S,
                                          float sink_l2  , float lam, f32x16* o, int tid, int wave, int lane) {
  constexpr int NCB = DV / 32, NPK = KW / 64, NPV = DV / 64;
  const int r32 = lane & 31, hi = lane >> 5;
  const int qoff = ZS ? 32 * (wave >> 1) : 32 * wave; const int kcolB = ZS ? (wave & 1) * 128 : 0;
  LAS float* wsf = (LAS float*)(lds + L_WS) + wave * 64; LAS float* li_l = wsf; LAS float* al_l = wsf + 32;
  float m_reg = -1e30f, l_reg = 0.f;
#pragma unroll
  for (int d = 0; d < NCB; ++d) o[d] = f32x16{};
  bf16x8 qr[4];
  { const bf16* Qw = Qrow0 + (size_t)(qoff + r32) * qpitch + (ZS ? (wave & 1) * 64 : 0) + hi * 8;
#pragma unroll
    for (int d0 = 0; d0 < 4; ++d0) qr[d0] = *(const bf16x8*)(Qw + d0 * 16); }
  const int ksr = (KW == 64) ? (tid >> 3) : (tid >> 4), ksc = (KW == 64) ? (tid & 7) * 8 : (tid & 15) * 8;
  const int vsr = (DV == 64) ? (tid >> 3) : (tid >> 4), vsc = (DV == 64) ? (tid & 7) * 8 : (tid & 15) * 8;
  const int vb0 = (int)(size_t)(lds + L_V) + v_rd_base(lane);
  bf16x8 kst[NPK], vst[NPV];
#define ATT_LOAD(j) do { const bool cx = (j) < S.nctx; const bf16* kb = cx ? S.kc + (size_t)((j) * 64) * S.cp : S.kl + (size_t)(S.lat0 + ((j) - S.nctx) * 64) * S.lp; \
    const bf16* vbp = cx ? S.vc + (size_t)((j) * 64) * S.cp : S.vl + (size_t)(S.lat0 + ((j) - S.nctx) * 64) * S.lp; const int pt = cx ? S.cp : S.lp; \
    _Pragma("unroll") for (int i = 0; i < NPK; ++i) kst[i] = *(const bf16x8*)(kb + (size_t)(ksr + 32 * i) * pt + ksc); \
    _Pragma("unroll") for (int i = 0; i < NPV; ++i) vst[i] = *(const bf16x8*)(vbp + (size_t)(vsr + 32 * i) * pt + vsc); } while (0)
#define ATT_WRITE() do { \
    _Pragma("unroll") for (int i = 0; i < NPK; ++i) *(LAS bf16x8*)(lds + L_K + kswz<KW>(ksr + 32 * i, ksc * 2)) = kst[i]; \
    _Pragma("unroll") for (int i = 0; i < NPV; ++i) *(LAS bf16x8*)(lds + L_V + v_st<NCB>(vsr + 32 * i, vsc)) = vst[i]; } while (0)
  ATT_LOAD(0);
  for (int j = 0; j < S.nt; ++j) {
    __syncthreads();
    ATT_WRITE();
    __syncthreads();
    if (j + 1 < S.nt) ATT_LOAD(j + 1);
    f32x16 p0, p1; float alpha; bf16x8 pa0, pa1, pa2, pa3;
    ATT_SBAR(); qkt<KW>(p0, p1, lds + L_K, kcolB, qr, r32, hi);
    if (S.mask && j >= S.nctx) {
      const int qpos = S.q0 + qoff + r32, kb0 = S.lat0 + (j - S.nctx) * 64;
#pragma unroll
      for (int r = 0; r < 16; ++r) { const int k0 = kb0 + crow(r, hi) - qpos; if (k0 > 128 || k0 < -128) p0[r] = -1e30f; const int k1 = k0 + 32; if (k1 > 128 || k1 < -128) p1[r] = -1e30f; }
    }
    partialSM(p0, p1, m_reg, alpha);
    if (__any(alpha < 1.f)) { if (hi == 0) al_l[r32] = alpha; asm volatile("s_waitcnt lgkmcnt(0)" ::: "memory");
#pragma unroll
      for (int d = 0; d < NCB; ++d)
#pragma unroll
        for (int r = 0; r < 16; ++r) o[d][r] *= al_l[crow(r, hi)]; }
    finishSM(p0, p1, alpha, l_reg, pa0, pa1, pa2, pa3); ATT_SBAR();
    pv_one<NCB, 0>(o[0], vb0, pa0, pa1, pa2, pa3); pv_one<NCB, 1>(o[1], vb0, pa0, pa1, pa2, pa3);
    if constexpr (NCB == 4) { pv_one<NCB, 2>(o[2], vb0, pa0, pa1, pa2, pa3); pv_one<NCB, 3>(o[3], vb0, pa0, pa1, pa2, pa3); }
  }
#undef ATT_LOAD
#undef ATT_WRITE
  float lt = l_reg + __builtin_amdgcn_exp2f(sink_l2 - m_reg * CSC);
  if (hi == 0) li_l[r32] = lt; asm volatile("s_waitcnt lgkmcnt(0)" ::: "memory");
  float rli[16];
#pragma unroll
  for (int r = 0; r < 16; ++r) rli[r] = __builtin_amdgcn_rcpf(li_l[crow(r, hi)]);
#pragma unroll
  for (int d = 0; d < NCB; ++d)
#pragma unroll
    for (int r = 0; r < 16; ++r) o[d][r] *= rli[r];
  if constexpr (ZS) {
    LAS float* cb = (LAS float*)(lds + L_CMB) + (wave >> 1) * 4096;
    if (wave & 1) {
#pragma unroll
      for (int d = 0; d < NCB; ++d)
#pragma unroll
        for (int r = 0; r < 16; ++r) cb[(d * 16 + r) * 64 + lane] = o[d][r];
    }
    __syncthreads();
    if (!(wave & 1)) {
#pragma unroll
      for (int d = 0; d < NCB; ++d)
#pragma unroll
        for (int r = 0; r < 16; ++r) o[d][r] -= lam * cb[(d * 16 + r) * 64 + lane];
    }
  }
}
#undef ATT_SBAR
}
namespace rw {
#define LDS_BARRIER() do { asm volatile("s_waitcnt lgkmcnt(0)" ::: "memory"); __builtin_amdgcn_s_barrier(); asm volatile("" ::: "memory"); } while (0)
typedef short bf16x8 __attribute__((ext_vector_type(8)));
typedef short bf16x4 __attribute__((ext_vector_type(4)));
typedef float f32x4 __attribute__((ext_vector_type(4)));
constexpr int R_KK = 0, R_RR = 2048, R_GG = 4096, R_VP = 8192, R_AKK = 10240, R_TI = 11264, R_MR = 12288, R_WC = 13312, REC_BYTES = 13568;
constexpr int RS = 72;
constexpr int S_R = 0, S_K = 4096, A_K = 8192, A_R = 10496, A_B = 12800, A_E = 15104, S_TW = 17408, S_AL = 19712, S_MU = 22016, SCR_BYTES = 23552;
typedef float f32x2_t __attribute__((ext_vector_type(2))); typedef __bf16 bf16x2_t __attribute__((ext_vector_type(2)));
__device__ __forceinline__ unsigned cvtpk(float lo, float hi) { const f32x2_t v = {lo, hi}; const bf16x2_t b = __builtin_convertvector(v, bf16x2_t); return __builtin_bit_cast(unsigned, b); }
__device__ __forceinline__ unsigned short f2b(float f) { return (unsigned short)cvtpk(f, f); }
typedef unsigned u32x2 __attribute__((ext_vector_type(2)));
__device__ __forceinline__ bf16x4 pack4(float a, float b, float c, float d) { const u32x2 w = {cvtpk(a, b), cvtpk(c, d)}; return __builtin_bit_cast(bf16x4, w); }
__device__ __forceinline__ bf16x8 packlo(const f32x4& c) { const bf16x4 p = pack4(c[0], c[1], c[2], c[3]); return (bf16x8){p[0], p[1], p[2], p[3], 0, 0, 0, 0}; }
__device__ __forceinline__ f32x4 mm16(const f32x4& xt, const f32x4& y) { return __builtin_amdgcn_mfma_f32_16x16x32_bf16(packlo(xt), packlo(y), (f32x4){0.f, 0.f, 0.f, 0.f}, 0, 0, 0); }

struct Consts { bf16x8 w2f[2], a2f[2]; float kk4[4]; float w0s, a0s, kas, rks; };
struct Win { bf16x8 a[3], m[3], n[3]; };
__device__ __forceinline__ void load_consts(const Params& P, LAS unsigned char* scr, int h, int dir, int gtid, int lane, Consts& K) {
    const int wq = (gtid >> 6), l15 = lane & 15, g = lane >> 4, c2 = h * 64 + 16 * wq + l15;
    K.w0s = P.in[I_W0][dir * 512 + c2]; K.a0s = P.in[I_A0][dir * 512 + c2]; K.kas = P.in[I_KA][c2]; K.rks = P.in[I_RK][c2];
#pragma unroll
    for (int nt = 0; nt < 4; ++nt) K.kk4[nt] = P.in[I_KK][h * 64 + 16 * nt + l15];
    const bf16* w2t = (const bf16*)(P.ws + WS_LORA) + ((size_t)(dir * 8 + h) * 64 + 16 * wq + l15) * 64; const bf16* a2t = w2t + 65536;
#pragma unroll
    for (int ks = 0; ks < 2; ++ks) { K.w2f[ks] = *(const bf16x8*)(w2t + 32 * ks + 8 * g); K.a2f[ks] = *(const bf16x8*)(a2t + 32 * ks + 8 * g); }
    LAS float* smu = (LAS float*)(scr + S_MU); const float* mu = P.in[I_MU];
    for (int i = gtid; i < 320; i += 256) { const int kind = i >> 6, cc = i & 63; smu[i] = mu[kind < 3 ? kind * 512 + h * 64 + cc : 1536 + (i - 192)]; }
}
__device__ __forceinline__ void prep_fetch(const Params& P, int rowbase, int T, int t0, int h, int dir, int gtid, Win& W) {
    const bf16* PR = (const bf16*)(P.ws + WS_PROJ);
    const int wqu = __builtin_amdgcn_readfirstlane(gtid >> 6), ln = gtid & 63;
#pragma unroll
    for (int q = 0; q < 3; ++q) { int p = wqu + 4 * q; if (p > 9) p = 9;
        const int kind = p >> 1, tl = ((p & 1) * 64 + ln) >> 3, c8 = (ln & 7) * 8;
        const int col = 1280 + (kind < 3 ? kind * 512 + h * 64 + c8 : 1536 + (kind - 3) * 64 + c8);
        const int tm = dir ? t0 + 15 - tl : t0 + tl; const int ta = dir ? tm + 1 : tm - 1, tn = dir ? tm - 1 : tm + 1;
        const int ca = ta < 0 ? 0 : (ta >= T ? T - 1 : ta), cn = tn < 0 ? 0 : (tn >= T ? T - 1 : tn);
        W.a[q] = *(const bf16x8*)(PR + (size_t)(rowbase + ca) * N0 + col); W.m[q] = *(const bf16x8*)(PR + (size_t)(rowbase + tm) * N0 + col); W.n[q] = *(const bf16x8*)(PR + (size_t)(rowbase + cn) * N0 + col); }
}
__device__ __forceinline__ void prep_chunk(const Params& P, LAS unsigned char* rec, LAS unsigned char* scr, int T, int t0, int dir, const Consts& K, const Win& W,
                                           float* bon_out, int bon_stride, int bon_wstride, int gtid, int lane) {
    const int wq = gtid >> 6, l15 = lane & 15, g = lane >> 4;
    LAS float* sR = (LAS float*)(scr + S_R); LAS float* sK = (LAS float*)(scr + S_K);
    LAS unsigned short* sTW = (LAS unsigned short*)(scr + S_TW); LAS unsigned short* sAL = (LAS unsigned short*)(scr + S_AL);
    LAS unsigned short* aK = (LAS unsigned short*)(scr + A_K); LAS unsigned short* aR = (LAS unsigned short*)(scr + A_R);
    LAS unsigned short* aB = (LAS unsigned short*)(scr + A_B); LAS unsigned short* aE = (LAS unsigned short*)(scr + A_E);
    const LAS float* smu = (const LAS float*)(scr + S_MU);
#ifdef PROBE_S1
    for (int rp_ = 0; rp_ < 2; ++rp_)
#endif
    {   const int wqu = __builtin_amdgcn_readfirstlane(gtid >> 6), ln = gtid & 63;
#pragma unroll
        for (int q = 0; q < 3; ++q) { const int p = wqu + 4 * q;
            if (p < 10) { const int kind = p >> 1, tl = ((p & 1) * 64 + ln) >> 3, c8 = (ln & 7) * 8;
                const int tm = dir ? t0 + 15 - tl : t0 + tl; const int ta = dir ? tm + 1 : tm - 1, tn = dir ? tm - 1 : tm + 1;
                const float ma = (ta >= 0 && ta < T) ? 0.5f : 0.f, mn = (tn >= 0 && tn < T) ? 0.5f : 0.f;
                const f32x4 mu0 = *(const LAS f32x4*)(smu + kind * 64 + c8), mu1 = *(const LAS f32x4*)(smu + kind * 64 + c8 + 4);
                float x[8];
#pragma unroll
                for (int e = 0; e < 8; ++e) { const float pm = bf2f((bf16)W.m[q][e]); x[e] = pm + (ma * bf2f((bf16)W.a[q][e]) + mn * bf2f((bf16)W.n[q][e]) - pm) * (e < 4 ? mu0[e] : mu1[e - 4]); }
                if (kind == 0) { *(LAS f32x4*)(sR + tl * 64 + c8) = (f32x4){x[0], x[1], x[2], x[3]}; *(LAS f32x4*)(sR + tl * 64 + c8 + 4) = (f32x4){x[4], x[5], x[6], x[7]}; }
                else if (kind == 1) { *(LAS f32x4*)(sK + tl * 64 + c8) = (f32x4){x[0], x[1], x[2], x[3]}; *(LAS f32x4*)(sK + tl * 64 + c8 + 4) = (f32x4){x[4], x[5], x[6], x[7]}; }
                else if (kind == 2) { LAS unsigned short* vp = (LAS unsigned short*)(rec + R_VP);
#pragma unroll
                    for (int e = 0; e < 8; ++e) vp[((c8 + e) * 4 + (tl >> 2)) * 4 + (tl & 3)] = f2b(x[e]); }
                else if (kind == 3) { float th[8];
#pragma unroll
                    for (int e = 0; e < 8; ++e) th[e] = 1.f - 2.f * __builtin_amdgcn_rcpf(1.f + __expf(2.f * x[e]));
                    *(LAS bf16x4*)(sTW + tl * RS + c8) = pack4(th[0], th[1], th[2], th[3]); *(LAS bf16x4*)(sTW + tl * RS + c8 + 4) = pack4(th[4], th[5], th[6], th[7]); }
                else { *(LAS bf16x4*)(sAL + tl * RS + c8) = pack4(x[0], x[1], x[2], x[3]); *(LAS bf16x4*)(sAL + tl * RS + c8 + 4) = pack4(x[4], x[5], x[6], x[7]); } } } }
    LDS_BARRIER();
#ifdef PROBE_S2
    for (int rp_ = 0; rp_ < 2; ++rp_)
#endif
    {   const int ch = 16 * wq + l15;
        f32x4 wp = {0.f, 0.f, 0.f, 0.f}, ap = {0.f, 0.f, 0.f, 0.f};
#pragma unroll
        for (int ks = 0; ks < 2; ++ks) { const bf16x8 ta = *(const LAS bf16x8*)(sTW + l15 * RS + 32 * ks + 8 * g), aa = *(const LAS bf16x8*)(sAL + l15 * RS + 32 * ks + 8 * g);
            wp = __builtin_amdgcn_mfma_f32_16x16x32_bf16(ta, K.w2f[ks], wp, 0, 0, 0); ap = __builtin_amdgcn_mfma_f32_16x16x32_bf16(aa, K.a2f[ks], ap, 0, 0, 0); }
        float e[4], av[4], rv[4], kkr[4], ke[4], cum[4], ssq[4], bs[4];
#pragma unroll
        for (int i = 0; i < 4; ++i) { const int tl = 4 * g + i;
            float kq[4];
#pragma unroll
            for (int nt = 0; nt < 4; ++nt) kq[nt] = sK[tl * 64 + 16 * nt + l15];
            ssq[i] = 0.f;
#pragma unroll
            for (int nt = 0; nt < 4; ++nt) { const float t2 = kq[nt] * K.kk4[nt]; ssq[i] += t2 * t2; }
            const float kv = (wq == 0) ? kq[0] : (wq == 1) ? kq[1] : (wq == 2) ? kq[2] : kq[3];
            const float kkc = (wq == 0) ? K.kk4[0] : (wq == 1) ? K.kk4[1] : (wq == 2) ? K.kk4[2] : K.kk4[3];
            rv[i] = sR[tl * 64 + ch];
            const float wl = -(K.w0s + wp[i]); const float sp = fmaxf(wl, 0.f) + __logf(1.f + __expf(-fabsf(wl)));
            e[i] = __expf(-sp - 0.5f);
            av[i] = __builtin_amdgcn_rcpf(1.f + __expf(-(K.a0s + ap[i])));
            kkr[i] = kv * kkc; ke[i] = kv * (1.f + (av[i] - 1.f) * K.kas);
            bs[i] = rv[i] * ke[i] * K.rks; }
#pragma unroll
        for (int i = 0; i < 4; ++i) {
#pragma unroll
            for (int o = 1; o < 16; o <<= 1) { ssq[i] += __shfl_xor(ssq[i], o); bs[i] += __shfl_xor(bs[i], o); }
            if (l15 == 0) bon_out[wq * bon_wstride + (4 * g + i) * bon_stride] = bs[i]; }
        cum[0] = e[0]; cum[1] = cum[0] + e[1]; cum[2] = cum[1] + e[2]; cum[3] = cum[2] + e[3];
        const float tot = cum[3];
        const float t0s = __shfl(tot, l15), t1s = __shfl(tot, l15 + 16), t2s = __shfl(tot, l15 + 32), t3s = __shfl(tot, l15 + 48);
        const float pre = (g > 0 ? t0s : 0.f) + (g > 1 ? t1s : 0.f) + (g > 2 ? t2s : 0.f);
        if (g == 0) *(LAS float*)(rec + R_WC + ch * 4) = __expf(-(t0s + t1s + t2s + t3s));
        const int ks = ch >> 5, hb = (ch >> 4) & 1, gk = (ch >> 2) & 3, ik = ch & 3;
        LAS unsigned short* KKp = (LAS unsigned short*)(rec + R_KK); LAS unsigned short* RRp = (LAS unsigned short*)(rec + R_RR);
        float bt[4], et[4];
#pragma unroll
        for (int i = 0; i < 4; ++i) { const int tl = 4 * g + i; const float cm = cum[i] + pre;
            const float kk = kkr[i] * __builtin_amdgcn_rsqf(fmaxf(ssq[i], 1e-24f));
            const float Wt = __expf(-cm), Wp = __expf(-(cm - e[i])), iW = __expf(cm);
            const float ktv = kk * Wp, rtv = rv[i] * Wt; bt[i] = kk * av[i] * iW; et[i] = ke[i] * iW;
            const unsigned short kb = f2b(ktv), rb = f2b(rtv);
            aK[tl * RS + ch] = kb; aR[tl * RS + ch] = rb; aB[tl * RS + ch] = f2b(bt[i]); aE[tl * RS + ch] = f2b(et[i]);
            KKp[((tl * 2 + ks) * 4 + gk) * 8 + 4 * hb + ik] = kb; RRp[((tl * 2 + ks) * 4 + gk) * 8 + 4 * hb + ik] = rb; }
        *(LAS bf16x4*)(rec + R_GG + (ch * 4 + g) * 16) = pack4(bt[0], bt[1], bt[2], bt[3]);
        *(LAS bf16x4*)(rec + R_GG + (ch * 4 + g) * 16 + 8) = pack4(et[0], et[1], et[2], et[3]); }
    LDS_BARRIER();
#ifdef PROBE_S3
    for (int rp_ = 0; rp_ < 2; ++rp_)
#endif
    {   const LAS unsigned short* ra = (wq == 0) ? aB : (wq & 1) ? aE : aB; const LAS unsigned short* cb = (wq < 2) ? aK : aR;
        f32x4 acc = {0.f, 0.f, 0.f, 0.f}, acct = {0.f, 0.f, 0.f, 0.f};
        bf16x8 fa[2], fb[2];
#pragma unroll
        for (int ks = 0; ks < 2; ++ks) { fa[ks] = *(const LAS bf16x8*)(ra + l15 * RS + 32 * ks + 8 * g); fb[ks] = *(const LAS bf16x8*)(cb + l15 * RS + 32 * ks + 8 * g); }
#pragma unroll
        for (int ks = 0; ks < 2; ++ks) acc = __builtin_amdgcn_mfma_f32_16x16x32_bf16(fa[ks], fb[ks], acc, 0, 0, 0);
#pragma unroll
        for (int i = 0; i < 4; ++i) { const int s = 4 * g + i; const bool keep = (wq < 2) ? (s < l15) : (s <= l15); if (!keep) acc[i] = 0.f; }
        if (wq == 0) {
#pragma unroll
            for (int ks = 0; ks < 2; ++ks) acct = __builtin_amdgcn_mfma_f32_16x16x32_bf16(fb[ks], fa[ks], acct, 0, 0, 0);
            f32x4 idm;
#pragma unroll
            for (int i = 0; i < 4; ++i) { const int s = 4 * g + i; if (!(l15 < s)) acct[i] = 0.f; idm[i] = (s == l15) ? 1.f : 0.f; }
            const f32x4 n2 = mm16(acct, acc), n2t = mm16(acc, acct);
            const f32x4 n4 = mm16(n2t, n2), n4t = mm16(n2, n2t);
            const f32x4 n8 = mm16(n4t, n4);
            const f32x4 r1 = mm16(idm + n4t, idm + n8);
            const f32x4 r2 = mm16(idm + n2t, r1);
            const f32x4 ti = mm16(idm - acct, r2);
            *(LAS bf16x4*)(rec + R_TI + (l15 * 4 + g) * 16) = pack4(-ti[0], -ti[1], -ti[2], -ti[3]); *(LAS bf16x4*)(rec + R_TI + (l15 * 4 + g) * 16 + 8) = pack4(0.f, 0.f, 0.f, 0.f); }
        else if (wq == 1) { *(LAS bf16x4*)(rec + R_AKK + (l15 * 4 + g) * 16) = pack4(0.f, 0.f, 0.f, 0.f); *(LAS bf16x4*)(rec + R_AKK + (l15 * 4 + g) * 16 + 8) = pack4(acc[0], acc[1], acc[2], acc[3]); }
        else if (wq == 2) *(LAS bf16x4*)(rec + R_MR + (l15 * 4 + g) * 16) = pack4(acc[0], acc[1], acc[2], acc[3]);
        else *(LAS bf16x4*)(rec + R_MR + (l15 * 4 + g) * 16 + 8) = pack4(acc[0], acc[1], acc[2], acc[3]); }
    LDS_BARRIER();
}
__device__ __forceinline__ void scan_chunk(const LAS unsigned char* rec, f32x4 (&acc)[4], float* ydst, int ystep, int wq, int lane) {
    const int l15 = lane & 15, g = lane >> 4;
    const bf16x8 kk0 = *(const LAS bf16x8*)(rec + R_KK + l15 * 128 + g * 16), kk1 = *(const LAS bf16x8*)(rec + R_KK + l15 * 128 + 64 + g * 16);
    const bf16x8 rr0 = *(const LAS bf16x8*)(rec + R_RR + l15 * 128 + g * 16), rr1 = *(const LAS bf16x8*)(rec + R_RR + l15 * 128 + 64 + g * 16);
    const bf16x8 akk = *(const LAS bf16x8*)(rec + R_AKK + (l15 * 4 + g) * 16), ti = *(const LAS bf16x8*)(rec + R_TI + (l15 * 4 + g) * 16), mr = *(const LAS bf16x8*)(rec + R_MR + (l15 * 4 + g) * 16);
    const bf16x4 vp = *(const LAS bf16x4*)(rec + R_VP + ((16 * wq + l15) * 4 + g) * 8);
    bf16x8 sf0, sf1;
    { const bf16x4 a = pack4(acc[0][0], acc[0][1], acc[0][2], acc[0][3]), b = pack4(acc[1][0], acc[1][1], acc[1][2], acc[1][3]);
      const bf16x4 c = pack4(acc[2][0], acc[2][1], acc[2][2], acc[2][3]), d = pack4(acc[3][0], acc[3][1], acc[3][2], acc[3][3]);
      sf0 = (bf16x8){a[0], a[1], a[2], a[3], b[0], b[1], b[2], b[3]}; sf1 = (bf16x8){c[0], c[1], c[2], c[3], d[0], d[1], d[2], d[3]}; }
    const bf16x8 v0 = (bf16x8){0, 0, 0, 0, vp[0], vp[1], vp[2], vp[3]};
    f32x4 X = {0.f, 0.f, 0.f, 0.f}, Y = {0.f, 0.f, 0.f, 0.f};
    X = __builtin_amdgcn_mfma_f32_16x16x32_bf16(kk0, sf0, X, 0, 0, 0); X = __builtin_amdgcn_mfma_f32_16x16x32_bf16(kk1, sf1, X, 0, 0, 0); X = __builtin_amdgcn_mfma_f32_16x16x32_bf16(akk, v0, X, 0, 0, 0);
    Y = __builtin_amdgcn_mfma_f32_16x16x32_bf16(rr0, sf0, Y, 0, 0, 0); Y = __builtin_amdgcn_mfma_f32_16x16x32_bf16(rr1, sf1, Y, 0, 0, 0);
    const bf16x4 xb = pack4(X[0], X[1], X[2], X[3]);
    const bf16x8 xf = (bf16x8){xb[0], xb[1], xb[2], xb[3], 0, 0, 0, 0};
    f32x4 U = {0.f, 0.f, 0.f, 0.f};
    U = __builtin_amdgcn_mfma_f32_16x16x32_bf16(ti, xf, U, 0, 0, 0);
    const bf16x4 ub = pack4(U[0], U[1], U[2], U[3]);
    const bf16x8 uv = (bf16x8){ub[0], ub[1], ub[2], ub[3], vp[0], vp[1], vp[2], vp[3]};
    Y = __builtin_amdgcn_mfma_f32_16x16x32_bf16(mr, uv, Y, 0, 0, 0);
#pragma unroll
    for (int mt = 0; mt < 4; ++mt) { const bf16x8 gg = *(const LAS bf16x8*)(rec + R_GG + ((16 * mt + l15) * 4 + g) * 16); const f32x4 wc = *(const LAS f32x4*)(rec + R_WC + (16 * mt + 4 * g) * 4);
        acc[mt] = __builtin_amdgcn_mfma_f32_16x16x32_bf16(gg, uv, acc[mt], 0, 0, 0); acc[mt] = acc[mt] * wc; }
#pragma unroll
    for (int i = 0; i < 4; ++i) ydst[(ptrdiff_t)(4 * g + i) * ystep + 16 * wq + l15] = Y[i];
}
__device__ __forceinline__ void post_item(const Params& P, int r, int t, int T, int h, int part, float bon) {
    const bf16* PR = (const bf16*)(P.ws + WS_PROJ); bf16* MIX = (bf16*)(P.ws + WS_MIX);
    const int c0 = h * 64 + part * 32;
    const f32x4* yf = (const f32x4*)((const float*)(P.ws + WS_YF) + (size_t)r * 512 + c0); const f32x4* yb = (const f32x4*)((const float*)(P.ws + WS_YB) + (size_t)r * 512 + c0);
    float y[32];
#pragma unroll
    for (int q = 0; q < 8; ++q) { const f32x4 a = yf[q], b = yb[q]; y[4 * q] = a[0] + b[0]; y[4 * q + 1] = a[1] + b[1]; y[4 * q + 2] = a[2] + b[2]; y[4 * q + 3] = a[3] + b[3]; }
    const bf16* p0 = PR + (size_t)r * N0; const bool hp = t > 0, hn = t + 1 < T;
    const bf16* pp = p0 - (hp ? N0 : 0); const bf16* pn = p0 + (hn ? N0 : 0); const float mp = hp ? 1.f : 0.f, mn = hn ? 1.f : 0.f;
    float s = 0.f;
#pragma unroll
    for (int i = 0; i < 32; ++i) s += y[i];
    s += __shfl_xor(s, 1); const float mean = s * (1.f / 64.f);
    float q2 = 0.f;
#pragma unroll
    for (int i = 0; i < 32; ++i) { y[i] -= mean; q2 += y[i] * y[i]; }
    q2 += __shfl_xor(q2, 1); const float rstd = __builtin_amdgcn_rsqf(q2 * (1.f / 64.f) + 64e-5f);
    const float* lnw = P.in[I_LNW] + c0; const float* lnb = P.in[I_LNB] + c0; const float* muv = P.in[I_MU] + 1024 + c0;
    v4u* dst = (v4u*)(MIX + (size_t)r * D + 512 + c0);
#pragma unroll
    for (int q = 0; q < 4; ++q) {
        const bf16x8 vc = *(const bf16x8*)(p0 + 2304 + c0 + 8 * q), gb = *(const bf16x8*)(p0 + 2944 + c0 + 8 * q), vp = *(const bf16x8*)(pp + 2304 + c0 + 8 * q), vn = *(const bf16x8*)(pn + 2304 + c0 + 8 * q);
        float o8[8];
#pragma unroll
        for (int e = 0; e < 8; ++e) { const int ii = 8 * q + e; const float pc = bf2f((bf16)vc[e]), pq = bf2f((bf16)vp[e]) * mp, pm = bf2f((bf16)vn[e]) * mn;
            const float xv = pc + (0.5f * (pq + pm) - pc) * muv[ii]; const float g = bf2f((bf16)gb[e]);
            o8[e] = (y[ii] * rstd * lnw[ii] + lnb[ii] + bon * xv) * silu_f(g); }
        dst[q] = (v4u){pk2(o8[0], o8[1]), pk2(o8[2], o8[3]), pk2(o8[4], o8[5]), pk2(o8[6], o8[7])};
    }
}
}
__device__ __forceinline__ void p6_mid(const Params& P, LAS unsigned char* lds, int G, int vcu, int wave, int lane, int tid) {
    LAS float* gp = (LAS float*)lds; LAS float* gs = gp + 3 * 1024; LAS float* sh = gs + 3 * 1024;
    for (int i = tid; i < 3 * 1024; i += 512) { const int j = i >> 10, k = i & 1023;
        gp[i] = mod_val(P, 0, j, 2048 + k) * P.in[I_NPOST][k];
        gs[i] = P.in[I_NPRE][1024 + k] * (1.f + mod_val(P, 1, j, 1024 + k)); sh[i] = mod_val(P, 1, j, k); }
    __syncthreads();
    const int gw = vcu * NWAVES + wave, NGW = G * NWAVES;
    bf16* XN = (bf16*)(P.ws + WS_XN); const float* Y = (const float*)(P.ws + WS_Y);
    for (int r = gw; r < M; r += NGW) {
        const f32x4* xr = (const f32x4*)xrow(P, r) + lane; const f32x4* yr = (const f32x4*)(Y + (size_t)r * D) + lane; const int j = modidx(r);
        f32x4 y[4], x[4]; float s = 0.f;
#pragma unroll
        for (int q = 0; q < 4; ++q) { y[q] = yr[64 * q]; x[q] = xr[64 * q]; s += (y[q].x * y[q].x + y[q].y * y[q].y) + (y[q].z * y[q].z + y[q].w * y[q].w); }
        const float rinv = 1.f / sqrtf(wave_sum(s) * (1.f / D) + NORM_EPS);
        float s1 = 0.f; f32x4* orow = (f32x4*)(P.out + OUT_Y + (size_t)r * D) + lane;
#pragma unroll
        for (int q = 0; q < 4; ++q) { const LAS float* g = gp + j * 1024 + 256 * q + 4 * lane;
            x[q].x += g[0] * y[q].x * rinv; x[q].y += g[1] * y[q].y * rinv; x[q].z += g[2] * y[q].z * rinv; x[q].w += g[3] * y[q].w * rinv;
            orow[64 * q] = x[q]; s1 += (x[q].x * x[q].x + x[q].y * x[q].y) + (x[q].z * x[q].z + x[q].w * x[q].w); }
        const float rinv1 = 1.f / sqrtf(wave_sum(s1) * (1.f / D) + NORM_EPS);
        unsigned long long* o8 = (unsigned long long*)(XN + (size_t)r * D) + lane;
#pragma unroll
        for (int q = 0; q < 4; ++q) { const int k = 256 * q + 4 * lane; const LAS float* g = gs + j * 1024 + k; const LAS float* b = sh + j * 1024 + k;
            const float o0 = x[q].x * rinv1 * g[0] + b[0], o1 = x[q].y * rinv1 * g[1] + b[1], o2 = x[q].z * rinv1 * g[2] + b[2], o3 = x[q].w * rinv1 * g[3] + b[3];
            o8[64 * q] = (unsigned long long)pk2(o0, o1) | ((unsigned long long)pk2(o2, o3) << 32); }
    }
    __syncthreads();
}
__device__ __forceinline__ void p10_final(const Params& P, LAS unsigned char* lds, int G, int vcu, int wave, int lane, int tid) {
    LAS float* gp = (LAS float*)lds;
    for (int i = tid; i < 3 * 1024; i += 512) { const int j = i >> 10, k = i & 1023; gp[i] = mod_val(P, 1, j, 2048 + k) * P.in[I_NPOST][1024 + k]; }
    __syncthreads();
    const int gw = vcu * NWAVES + wave, NGW = G * NWAVES;
    const float* Y = (const float*)(P.ws + WS_Y);
    for (int r = gw; r < M; r += NGW) {
        f32x4* orow = (f32x4*)(P.out + OUT_Y + (size_t)r * D) + lane; const f32x4* yr = (const f32x4*)(Y + (size_t)r * D) + lane; const int j = modidx(r);
        f32x4 y[4], x[4]; float s = 0.f;
#pragma unroll
        for (int q = 0; q < 4; ++q) { y[q] = yr[64 * q]; x[q] = orow[64 * q]; s += (y[q].x * y[q].x + y[q].y * y[q].y) + (y[q].z * y[q].z + y[q].w * y[q].w); }
        const float rinv = 1.f / sqrtf(wave_sum(s) * (1.f / D) + NORM_EPS);
#pragma unroll
        for (int q = 0; q < 4; ++q) { const LAS float* g = gp + j * 1024 + 256 * q + 4 * lane;
            x[q].x += g[0] * y[q].x * rinv; x[q].y += g[1] * y[q].y * rinv; x[q].z += g[2] * y[q].z * rinv; x[q].w += g[3] * y[q].w * rinv;
            orow[64 * q] = x[q]; }
    }
    __syncthreads();
}
__device__ __forceinline__ void attnA_unit(const Params& P, LAS unsigned char* lds, bool sample, int b, int h, int qb, int tid, int wave, int lane) {
    asm volatile("" : "+v"(tid), "+v"(lane));
    const bf16* PR = (const bf16*)(P.ws + WS_PROJ); bf16* MIX = (bf16*)(P.ws + WS_MIX);
    const int g = h >> 2; att::Src S; int rowQ0;
    if (sample) { rowQ0 = MP + b * 2048 + qb * 256;
        S.kc = (const bf16*)(P.ws + WS_CAK) + (size_t)b * 256 * 128 + g * 64; S.vc = (const bf16*)(P.ws + WS_CAV) + (size_t)b * 256 * 128 + g * 64; S.cp = 128; S.nctx = 4;
        S.kl = PR + (size_t)(MP + b * 2048) * N0 + 512 + g * 64; S.vl = PR + (size_t)(MP + b * 2048) * N0 + 640 + g * 64; S.lp = N0;
        const int k0 = qb * 256 - 128 < 0 ? 0 : qb * 256 - 128, k1 = qb * 256 + 384 > 2048 ? 2048 : qb * 256 + 384;
        S.lat0 = k0; S.nt = 4 + (k1 - k0) / 64; S.q0 = qb * 256; S.mask = true;
    } else { rowQ0 = b * 256;
        S.kc = nullptr; S.vc = nullptr; S.cp = 0; S.nctx = 0; S.kl = PR + (size_t)(b * 256) * N0 + 512 + g * 64; S.vl = PR + (size_t)(b * 256) * N0 + 640 + g * 64; S.lp = N0;
        S.lat0 = 0; S.nt = 4; S.q0 = 0; S.mask = false; }
    att::f32x16 o[2];
    att::attn_unit<64, 64, false>(lds, PR + (size_t)rowQ0 * N0 + h * 64, N0, S, P.in[I_SINK][h] * 1.4426950408889634f, 0.f, o, tid, wave, lane);
    const int r32 = lane & 31, hi = lane >> 5;
#pragma unroll
    for (int r = 0; r < 16; ++r) { const int row = rowQ0 + 32 * wave + att::crow(r, hi);
#pragma unroll
        for (int d = 0; d < 2; ++d) { const int col = h * 64 + 32 * d + r32; const float ga = bf2f(PR[(size_t)row * N0 + 768 + col]);
            MIX[(size_t)row * D + col] = (bf16)f2bf(o[d][r] * silu_f(ga)); } }
}
__device__ __forceinline__ void attnC_unit(const Params& P, LAS unsigned char* lds, bool sample, int b, int h, int qb, float lam, int tid, int wave, int lane) {
    asm volatile("" : "+v"(tid), "+v"(lane));
    const bf16* PR = (const bf16*)(P.ws + WS_PROJ); bf16* MIX = (bf16*)(P.ws + WS_MIX);
    att::Src S; int rowQ0;
    if (sample) { rowQ0 = MP + b * 2048 + qb * 128;
        S.kc = (const bf16*)(P.ws + WS_CCK) + (size_t)b * 256 * 1024 + h * 128; S.vc = (const bf16*)(P.ws + WS_CCV) + (size_t)b * 256 * 1024 + h * 128; S.cp = 1024; S.nctx = 4;
        S.kl = PR + (size_t)(MP + b * 2048) * N1 + 1024 + h * 128; S.vl = PR + (size_t)(MP + b * 2048) * N1 + 2048 + h * 128; S.lp = N1; S.lat0 = 0; S.nt = 36; S.q0 = qb * 128; S.mask = false;
    } else { rowQ0 = b * 256 + qb * 128;
        S.kc = nullptr; S.vc = nullptr; S.cp = 0; S.nctx = 0; S.kl = PR + (size_t)(b * 256) * N1 + 1024 + h * 128; S.vl = PR + (size_t)(b * 256) * N1 + 2048 + h * 128; S.lp = N1;
        S.lat0 = 0; S.nt = 4; S.q0 = qb * 128; S.mask = false; }
    att::f32x16 o[4];
    att::attn_unit<128, 128, true>(lds, PR + (size_t)rowQ0 * N1 + h * 128, N1, S, -INFINITY, lam, o, tid, wave, lane);
    if (!(wave & 1)) {
        const int r32 = lane & 31, hi = lane >> 5; const float sc = 1.f - 0.35550906759f;
        float rs[16];
#pragma unroll
        for (int r = 0; r < 16; ++r) { float s = o[0][r] * o[0][r] + o[1][r] * o[1][r] + o[2][r] * o[2][r] + o[3][r] * o[3][r];
            s += __shfl_xor(s, 1); s += __shfl_xor(s, 2); s += __shfl_xor(s, 4); s += __shfl_xor(s, 8); s += __shfl_xor(s, 16);
            rs[r] = sc / sqrtf(s * (1.f / 128.f) + 1e-5f); }
#pragma unroll
        for (int r = 0; r < 16; ++r) { const int row = rowQ0 + 32 * (wave >> 1) + att::crow(r, hi);
#pragma unroll
            for (int d = 0; d < 4; ++d) { const int cc = 32 * d + r32; const float gc = bf2f(PR[(size_t)row * N1 + 3072 + h * 128 + cc]);
                MIX[(size_t)row * D + h * 128 + cc] = (bf16)f2bf(o[d][r] * rs[r] * P.in[I_SUBLN][cc] * silu_f(gc)); } }
    }
}
constexpr int RW_REC1 = 27136  , RW_SCR0 = 57344, RW_BON = 106496;
__device__ __forceinline__ void rw_prep_item_sample(const Params& P, LAS unsigned char* lds, int b, int cidx, int h, int tid, int lane) {
    asm volatile("" : "+v"(tid), "+v"(lane));
    const int dir = tid >> 8, gtid = tid & 255;
    LAS unsigned char* rec = lds + dir * rw::REC_BYTES; LAS unsigned char* scr = lds + RW_SCR0 + dir * rw::SCR_BYTES;
    rw::Consts K; rw::load_consts(P, scr, h, dir, gtid, lane, K);
    const int t0 = cidx * 16;
    rw::Win W; rw::prep_fetch(P, MP + b * 2048, 2048, t0, h, dir, gtid, W);
    float* bon = (float*)(P.ws + WS_BONUS) + (size_t)((dir * 2 + b) * 8 + h) * 4 * 2048 + (dir ? t0 + 15 : t0);
    __syncthreads();
    rw::prep_chunk(P, rec, scr, 2048, t0, dir, K, W, bon, dir ? -1 : 1, 2048, gtid, lane);
    const int ci = dir ? 127 - cidx : cidx;
    v4u* dst = (v4u*)(P.ws + WS_REC + ((size_t)((b * 8 + h) * 2 + dir) * 128 + ci) * rw::REC_BYTES);
    for (int i = gtid; i < rw::REC_BYTES / 16; i += 256) dst[i] = *(const LAS v4u*)(rec + i * 16);
}
__device__ __forceinline__ void rw_scan_unit_sample(const Params& P, LAS unsigned char* lds, int b, int h, int tid, int wave, int lane) {
    asm volatile("" : "+v"(tid), "+v"(lane));
    const int dir = tid >> 8, wq = (tid >> 6) & 3, l15 = lane & 15, g = lane >> 4;
    const int wqu = __builtin_amdgcn_readfirstlane(wq), diru = __builtin_amdgcn_readfirstlane(dir);
    LAS unsigned char* ring = lds + diru * 65536;
    const unsigned char* src = P.ws + WS_REC + (size_t)((b * 8 + h) * 2 + dir) * 128 * rw::REC_BYTES;
    rw::f32x4 acc[4];
    { const float* s0 = P.in[I_ST] + ((((size_t)b * 2 + dir) * 8 + h) * 64 + 16 * wq + l15) * 64 + 4 * g;
#pragma unroll
      for (int mt = 0; mt < 4; ++mt) acc[mt] = *(const rw::f32x4*)(s0 + 16 * mt); }
    __syncthreads();
#define RW_DMA(ci_) do { const unsigned char* s_ = src + (size_t)(ci_) * rw::REC_BYTES + lane * 16; LAS unsigned char* d_ = ring + ((ci_) & 3) * 16384; \
        _Pragma("unroll") for (int q_ = 0; q_ < 4; ++q_) __builtin_amdgcn_global_load_lds((const unsigned*)(s_ + (wqu + 4 * q_) * 1024), (LAS unsigned*)(d_ + (wqu + 4 * q_) * 1024), 16, 0, 0); } while (0)
    RW_DMA(0); RW_DMA(1); RW_DMA(2);
    float* ybase = (float*)(P.ws + (dir ? WS_YB : WS_YF)) + (size_t)(MP + b * 2048) * 512 + h * 64;
    for (int ci = 0; ci < 128; ++ci) {
        if (ci >= 3 && ci + 3 <= 128) asm volatile("s_waitcnt vmcnt(20)" ::: "memory"); else asm volatile("s_waitcnt vmcnt(0)" ::: "memory");
        __builtin_amdgcn_s_barrier(); asm volatile("" ::: "memory");
        if (ci + 3 < 128) RW_DMA(ci + 3);
        float* yd = ybase + (size_t)(dir ? 2047 - ci * 16 : ci * 16) * 512;
        rw::scan_chunk(ring + (ci & 3) * 16384, acc, yd, dir ? -512 : 512, wq, lane);
        asm volatile("s_waitcnt lgkmcnt(0)" ::: "memory");
    }
#undef RW_DMA
    asm volatile("s_waitcnt vmcnt(0)" ::: "memory");
}
__device__ __forceinline__ void rw_post_sample(const Params& P, int G, int vcu, int tid) {
    const float* BON = (const float*)(P.ws + WS_BONUS);
    for (int it = vcu * 512 + tid; it < MS * 8 * 2; it += G * 512) { const int part = it & 1, h = (it >> 1) & 7, tok = it >> 4, b = tok >> 11, t = tok & 2047;
        const float* bf_ = BON + (size_t)(b * 8 + h) * 4 * 2048 + t; const float* bb_ = BON + (size_t)((2 + b) * 8 + h) * 4 * 2048 + t;
        const float bon = 0.5f * ((bf_[0] + bf_[2048]) + (bf_[4096] + bf_[6144]) + (bb_[0] + bb_[2048]) + (bb_[4096] + bb_[6144]));
        rw::post_item(P, MP + tok, t, 2048, h, part, bon); }
}
__device__ __forceinline__ void rw_unit_prompt(const Params& P, LAS unsigned char* lds, int b, int h, int tid, int wave, int lane) {
    asm volatile("" : "+v"(tid), "+v"(lane));
    const int dir = tid >> 8, gtid = tid & 255, wq = (tid >> 6) & 3, l15 = lane & 15, g = lane >> 4;
    LAS unsigned char* scr = lds + RW_SCR0 + dir * rw::SCR_BYTES;
    float* bonl = (float*)((LAS float*)(lds + RW_BON));
    rw::Consts K; rw::load_consts(P, scr, h, dir, gtid, lane, K);
    rw::f32x4 acc[4];
#pragma unroll
    for (int mt = 0; mt < 4; ++mt) acc[mt] = (rw::f32x4){0.f, 0.f, 0.f, 0.f};
    float* ybase = (float*)(P.ws + (dir ? WS_YB : WS_YF)) + (size_t)(b * 256) * 512 + h * 64;
    rw::Win W; rw::prep_fetch(P, b * 256, 256, dir ? 240 : 0, h, dir, gtid, W);
    unsigned pfx = 0u;
    {
        const bf16* PR = (const bf16*)(P.ws + WS_PROJ) + (size_t)(b * 256) * N0 + 1280;
#pragma unroll
        for (int q = 0; q < 3; ++q) { const int i = tid + 512 * q; if (i < 1280) { const int row = i / 5, sg = i % 5; const bf16* p = PR + (size_t)row * N0 + (sg < 3 ? sg * 512 + h * 64 : 1536 + (sg - 3) * 64);
            pfx ^= *(const unsigned*)p; } }
    }
    __syncthreads();
#ifdef PROBE_HALF
    for (int cj = 0; cj < 32; ++cj) { const int ci = cj & 15;
        if (cj == 16) { for (int mt = 0; mt < 4; ++mt) acc[mt] = (rw::f32x4){0.f, 0.f, 0.f, 0.f}; }
#else
    for (int ci = 0; ci < 16; ++ci) {
#endif
        const int t0 = dir ? 240 - ci * 16 : ci * 16;
        int gt2 = gtid, ln2 = lane; asm volatile("" : "+v"(gt2), "+v"(ln2));
        LAS unsigned char* rec = lds + (ci & 1) * RW_REC1 + dir * rw::REC_BYTES;
        #ifdef PROBE_HALF
        rw::Win W2; const int cn = (cj + 1) & 15; rw::prep_fetch(P, b * 256, 256, dir ? 240 - cn * 16 : cn * 16, h, dir, gt2, W2);
#else
        rw::Win W2; const int cn = ci < 15 ? ci + 1 : 15; rw::prep_fetch(P, b * 256, 256, dir ? 240 - cn * 16 : cn * 16, h, dir, gt2, W2);
#endif
        rw::prep_chunk(P, rec, scr, 256, t0, dir, K, W, bonl + dir * 1024 + (dir ? t0 + 15 : t0), dir ? -1 : 1, 256, gt2, ln2);
        float* yd = ybase + (size_t)(dir ? t0 + 15 : t0) * 512;
        asm volatile("" : "+v"(ln2));
        rw::scan_chunk(rec, acc, yd, dir ? -512 : 512, wq, ln2);
        W = W2;
    }
    asm volatile("" :: "v"(pfx));
    { float* so = P.out + OUT_ST + ((((size_t)b * 2 + dir) * 8 + h) * 64 + 16 * wq + l15) * 64 + 4 * g;
#pragma unroll
      for (int mt = 0; mt < 4; ++mt) *(rw::f32x4*)(so + 16 * mt) = acc[mt]; }
    asm volatile("s_waitcnt vmcnt(0)" ::: "memory"); __syncthreads(); __builtin_amdgcn_fence(__ATOMIC_ACQUIRE, "agent");
    { const int t = tid >> 1; const float* bq = bonl + t;
      const float bon = 0.5f * ((bq[0] + bq[256]) + (bq[512] + bq[768]) + (bq[1024] + bq[1280]) + (bq[1536] + bq[1792]));
      rw::post_item(P, b * 256 + t, t, 256, h, tid & 1, bon);
#ifdef PROBE_POST2
      asm volatile("" ::: "memory"); rw::post_item(P, b * 256 + t, t, 256, h, tid & 1, bon);
#endif
    }
}
constexpr int NPH = 12;
#ifndef DBL_MASK
#define DBL_MASK 0
#endif
#define REPS(k) ((((DBL_MASK) >> (k)) & 1) + 1)
__global__ void __launch_bounds__(NWAVES * 64, 2) mega_fwd(Params P) {
    extern __shared__ __attribute__((aligned(16))) unsigned char lds_raw[];
    LAS unsigned char* lds = (LAS unsigned char*)lds_raw;
    volatile LAS unsigned* MISC = (volatile LAS unsigned*)(lds + MISC_OFF);
    const int tid = threadIdx.x, lane = tid & 63, wave = __builtin_amdgcn_readfirstlane(tid >> 6);
    const int G = gridDim.x; const int bx = blockIdx.x; const int vcu = (G % 8 == 0) ? (bx % 8) * (G / 8) + bx / 8 : bx;
    gu32* ctl = (gu32*)(P.ws + WS_CTL);
    for (int u = tid; u < (LDS_BYTES - LDSCTL_OFF) / 4; u += NWAVES * 64) ((LAS unsigned*)(lds + LDSCTL_OFF))[u] = 0u;
    __syncthreads();
    XcdBarrier bar = xcd_barrier_post((unsigned*)(ctl + CW_BAR), MISC + 8);
    const int lo = P.ph_lo, hi = P.ph_hi;
#define IN(k) (lo <= (k) && (k) < hi)
#define SEAM(k) do { if (IN(k) && IN((k) + 1)) xcd_barrier(bar); } while (0)

    if (IN(0)) for (int rep_ = 0; rep_ < REPS(0); ++rep_) { p0_prologue(P, lds, G, vcu, wave, lane, tid); } SEAM(0);
    if (IN(1)) for (int rep_ = 0; rep_ < REPS(1); ++rep_) { p1_hprep(P, lds, G, vcu, wave, lane, tid); } SEAM(1);
    if (IN(2)) for (int rep_ = 0; rep_ < REPS(2); ++rep_) {
        pg8::Gemm g{(const pg8::bf16_t*)(P.ws + WS_XN), (const pg8::bf16_t*)(P.ws + WS_WT0), M, N0P, D}; pg8::StaticOrder S; S.init(M, N0P, G, bx);
        pg8::EpiIn E{(pg8::bf16_t*)(P.ws + WS_PROJ), N0, N0, 640, (const float*)(P.ws + WS_ROPE), P.out + OUT_AK, P.out + OUT_AV, 512, 640, 640, 768, 128, 128};
        pg8::gemm_phase<pg8::EpiIn, pg8::StaticOrder, true, true>(lds, g, S, E);
    } SEAM(2);
    if (IN(3)) for (int rep_ = 0; rep_ < REPS(3); ++rep_) {
        if (G >= 64 && bx < 16) { const int u = 240 + bx; rw_unit_prompt(P, lds, u >> 3, u & 7, tid, wave, lane); __syncthreads(); }
        else { const int nb = (G >= 64) ? G - 16 : G, b0 = (G >= 64) ? bx - 16 : bx;
        for (int u = b0; u < 384 + 2048; u += nb) {
            if (u < 128) attnA_unit(P, lds, true, u >> 6, (u >> 3) & 7, u & 7, tid, wave, lane);
            else if (u < 384) { const int i = u - 128; attnA_unit(P, lds, false, i >> 3, i & 7, 0, tid, wave, lane); }
            else { const int i = u - 384; rw_prep_item_sample(P, lds, i >> 10, (i >> 3) & 127, i & 7, tid, lane); }
            __syncthreads();
        } }
    } SEAM(3);
    if (IN(4)) for (int rep_ = 0; rep_ < REPS(4); ++rep_) {
        if (G >= 64) {
            if (bx < 16) { rw_scan_unit_sample(P, lds, bx >> 3, bx & 7, tid, wave, lane); __syncthreads(); }
            else for (int u = bx - 16; u < 240; u += G - 16) { rw_unit_prompt(P, lds, u >> 3, u & 7, tid, wave, lane); __syncthreads(); }
        } else {
            for (int u = bx; u < 272; u += G) {
                if (u < 16) rw_scan_unit_sample(P, lds, u >> 3, u & 7, tid, wave, lane);
                else rw_unit_prompt(P, lds, (u - 16) >> 3, (u - 16) & 7, tid, wave, lane);
                __syncthreads();
            }
        }
    } SEAM(4);
    if (IN(5)) for (int rep_ = 0; rep_ < REPS(5); ++rep_) { rw_post_sample(P, G, vcu, tid); } SEAM(5);
    if (IN(6)) for (int rep_ = 0; rep_ < REPS(6); ++rep_) {
        pg8::Gemm g{(const pg8::bf16_t*)(P.ws + WS_MIX), (const pg8::bf16_t*)(P.ws + WS_WO0), M, D, D}; pg8::StaticOrder S; S.init(M, D, G, bx);
        pg8::EpiF32 E{(float*)(P.ws + WS_Y), D};
        pg8::gemm_phase<pg8::EpiF32, pg8::StaticOrder, true, true>(lds, g, S, E);
    } SEAM(6);
    if (IN(7)) for (int rep_ = 0; rep_ < REPS(7); ++rep_) { p6_mid(P, lds, G, vcu, wave, lane, tid); } SEAM(7);
    if (IN(8)) for (int rep_ = 0; rep_ < REPS(8); ++rep_) {
        pg8::Gemm g{(const pg8::bf16_t*)(P.ws + WS_XN), (const pg8::bf16_t*)(P.ws + WS_WT1), M, N1, D}; pg8::StaticOrder S; S.init(M, N1, G, bx);
        pg8::EpiIn E{(pg8::bf16_t*)(P.ws + WS_PROJ), N1, N1, 2048, (const float*)(P.ws + WS_ROPE), P.out + OUT_CK, P.out + OUT_CV, 1024, 2048, 2048, 3072, 1024, 1024};
        pg8::gemm_phase<pg8::EpiIn, pg8::StaticOrder, true, true>(lds, g, S, E);
    } SEAM(8);
    if (IN(9)) for (int rep_ = 0; rep_ < REPS(9); ++rep_) {
        const float d1 = wave_sum(P.in[I_LQ1][lane] * P.in[I_LK1][lane]), d2 = wave_sum(P.in[I_LQ2][lane] * P.in[I_LK2][lane]);
        const float lam = expf(d1) - expf(d2) + 0.35550906759f;
        for (int u = bx; u < 768; u += G) {
            if (u < 256) attnC_unit(P, lds, true, u >> 7, (u >> 4) & 7, u & 15, lam, tid, wave, lane);
            else { const int i = u - 256; attnC_unit(P, lds, false, i >> 4, (i >> 1) & 7, i & 1, lam, tid, wave, lane); }
            __syncthreads();
        }
    } SEAM(9);
    if (IN(10)) for (int rep_ = 0; rep_ < REPS(10); ++rep_) {
        pg8::Gemm g{(const pg8::bf16_t*)(P.ws + WS_MIX), (const pg8::bf16_t*)(P.ws + WS_WO1), M, D, D}; pg8::StaticOrder S; S.init(M, D, G, bx);
        pg8::EpiF32 E{(float*)(P.ws + WS_Y), D};
        pg8::gemm_phase<pg8::EpiF32, pg8::StaticOrder, true, true>(lds, g, S, E);
    } SEAM(10);
    if (IN(11)) for (int rep_ = 0; rep_ < REPS(11); ++rep_) { p10_final(P, lds, G, vcu, wave, lane, tid); }
#undef IN
#undef SEAM
}

extern "C" void kernel_launch(void* const* d_in, const int* in_sizes, int n_in, void* d_out, int out_size, void* d_ws, size_t ws_size, hipStream_t stream) {
    static int grid = 0;
    if (grid == 0) {
        if (n_in != 32 || out_size != 33554432 || ws_size < WS_END) { fprintf(stderr, "kernel_launch: unexpected shapes (n_in %d out %d ws %zu)\n", n_in, out_size, ws_size); grid = -1; return; }
        int dev = 0, cus = 0, per_cu = 0;
        if (hipGetDevice(&dev) != hipSuccess || hipDeviceGetAttribute(&cus, hipDeviceAttributeMultiprocessorCount, dev) != hipSuccess) { grid = -1; return; }
        if (hipFuncSetAttribute((const void*)mega_fwd, hipFuncAttributeMaxDynamicSharedMemorySize, LDS_BYTES) != hipSuccess) { fprintf(stderr, "kernel_launch: hipFuncSetAttribute failed\n"); grid = -1; return; }
        if (hipOccupancyMaxActiveBlocksPerMultiprocessor(&per_cu, (const void*)mega_fwd, NWAVES * 64, LDS_BYTES) != hipSuccess || per_cu < 1) { fprintf(stderr, "kernel_launch: occupancy query says %d\n", per_cu); per_cu = 1; }
        (void)hipGetLastError();
        grid = cus;
    }
    if (grid < 0) return;
    (void)hipMemsetAsync((char*)d_ws + WS_CTL, 0, CTL_ZERO_BYTES, stream);
    Params a{};
    for (int i = 0; i < 32; ++i) a.in[i] = (const float*)d_in[i];
    a.out = (float*)d_out; a.ws = (unsigned char*)d_ws;
#ifndef MK_PER_PHASE
    a.ph_lo = 0; a.ph_hi = NPH;
    hipLaunchKernelGGL(mega_fwd, dim3(grid), dim3(NWAVES * 64), LDS_BYTES, stream, a);
#else
    for (int p = 0; p < NPH; ++p) { a.ph_lo = p; a.ph_hi = p + 1; hipLaunchKernelGGL(mega_fwd, dim3(grid), dim3(NWAVES * 64), LDS_BYTES, stream, a); }
#endif
    const hipError_t le = hipPeekAtLastError();
    if (le != hipSuccess) fprintf(stderr, "kernel_launch: launch failed: %s\n", hipGetErrorName(le));
}
```
